# Optimizing an MI355X kernel written in HIP

```python
import jax, jax.numpy as jnp
from jax import lax
import numpy as np

D_MODEL = 2048
BATCH = 2
SEQ = 8192
DEPTH = 1

RET_HEADS = 4
RET_HEAD_DIM = D_MODEL // 8
RET_WIDTH = RET_HEADS * RET_HEAD_DIM
HGRN_HEADS = 8
HGRN_HEAD_DIM = D_MODEL // 16
HGRN_WIDTH = HGRN_HEADS * HGRN_HEAD_DIM
MIX_WIDTH = RET_WIDTH + HGRN_WIDTH
IN_COLS = 4 * RET_WIDTH + 4 * HGRN_WIDTH
D_FF = ((8 * D_MODEL // 3 + 255) // 256) * 256
RET_CHUNK = 128
HGRN_CHUNK = 64
ROPE_BASE = 10000.0
EPS = 1e-6
FFN_RESIDUAL_WEIGHT = 0.5

kernel_name = "hymba_style_retention_hgrn2_macaron"


def rmsnorm(x, g):
    x32 = x.astype(jnp.float32)
    y = x32 * lax.rsqrt(jnp.mean(x32 * x32, axis=-1, keepdims=True) + EPS)
    return (y * g.astype(jnp.float32)).astype(x.dtype)


def swiglu(h, w_gate, w_up, w_down):
    return (jax.nn.silu(h @ w_gate) * (h @ w_up)) @ w_down


def rope(x):
    d = x.shape[-1]
    s = x.shape[1]
    inv = jnp.power(ROPE_BASE, -jnp.arange(0, d, 2, dtype=jnp.float32) / d)
    ang = jnp.arange(s, dtype=jnp.float32)[:, None] * inv[None, :]
    cos = jnp.cos(ang)[None, :, None, :]
    sin = jnp.sin(ang)[None, :, None, :]
    x32 = x.astype(jnp.float32)
    x1, x2 = x32[..., : d // 2], x32[..., d // 2:]
    return jnp.concatenate([x1 * cos - x2 * sin, x2 * cos + x1 * sin], axis=-1)


def retention_chunkwise(q, k, v):
    b, s, h, dk = q.shape
    dv = v.shape[-1]
    c = RET_CHUNK
    n = s // c
    log_gamma = jnp.log(1.0 - jnp.exp2(-5.0 - jnp.arange(h, dtype=jnp.float32)))
    q = q.astype(jnp.float32).reshape(b, n, c, h, dk)
    k = k.astype(jnp.float32).reshape(b, n, c, h, dk)
    v = v.astype(jnp.float32).reshape(b, n, c, h, dv)
    idx = jnp.arange(c, dtype=jnp.float32)
    rel = idx[:, None] - idx[None, :]
    mask = rel >= 0
    decay = jnp.where(mask[None], jnp.exp(log_gamma[:, None, None] * jnp.where(mask, rel, 0.0)[None]), 0.0)
    scores = jnp.einsum('bnihd,bnjhd->bnhij', q, k) * decay[None, None]
    inner = jnp.einsum('bnhij,bnjhe->bnihe', scores, v)
    k_dec = k * jnp.exp(log_gamma[None, :] * (c - 1.0 - idx)[:, None])[None, None, :, :, None]
    kv = jnp.einsum('bnjhd,bnjhe->nbhde', k_dec, v)
    g_chunk = jnp.exp(log_gamma * c)[None, :, None, None]

    def step(state, kv_n):
        return g_chunk * state + kv_n, state

    _, r_prev = lax.scan(step, jnp.zeros((b, h, dk, dv), jnp.float32), kv)
    q_dec = q * jnp.exp(log_gamma[None, :] * (idx + 1.0)[:, None])[None, None, :, :, None]
    cross = jnp.einsum('bnihd,nbhde->bnihe', q_dec, r_prev)
    return (inner + cross).reshape(b, s, h, dv)


def hgrn2_chunkwise(q, k, v, log_f):
    b, s, h, dk = q.shape
    dv = v.shape[-1]
    c = HGRN_CHUNK
    n = s // c

    def to_chunks(t):
        return t.astype(jnp.float32).reshape(b, n, c, h, t.shape[-1]).transpose(1, 0, 3, 2, 4)

    causal = jnp.tril(jnp.ones((c, c), dtype=bool))

    def step(state, inp):
        q_c, k_c, v_c, lf_c = inp
        cum = jnp.cumsum(lf_c, axis=-2)
        diff = cum[:, :, :, None, :] - cum[:, :, None, :, :]
        pair_decay = jnp.exp(jnp.where(causal[:, :, None], diff, -jnp.inf))
        attn = jnp.einsum('bhtd,bhjd,bhtjd->bhtj', q_c, k_c, pair_decay)
        o = jnp.einsum('bhtj,bhje->bhte', attn, v_c) + jnp.einsum('bhtd,bhde->bhte', q_c * jnp.exp(cum), state)
        last = cum[:, :, -1:, :]
        state = jnp.exp(last[:, :, 0, :])[..., None] * state + jnp.einsum('bhjd,bhje->bhde', k_c * jnp.exp(last - cum), v_c)
        return state, o

    _, o = lax.scan(step, jnp.zeros((b, h, dk, dv), jnp.float32),
                    (to_chunks(q), to_chunks(k), to_chunks(v), to_chunks(log_f)))
    return o.transpose(1, 0, 3, 2, 4).reshape(b, s, h, dv)


def hgrn_lower_bounds(lb_logits):
    logits = jnp.concatenate([lb_logits.astype(jnp.float32), jnp.zeros((1, lb_logits.shape[-1]), jnp.float32)], axis=0)
    return jnp.cumsum(jax.nn.softmax(logits, axis=0), axis=0)[:DEPTH]


def hybrid_mixer(h, w_in, ret_norm_g, lb, hgrn_norm_g, w_out):
    b, s, _ = h.shape
    proj = h @ w_in
    splits = np.cumsum([RET_WIDTH] * 4 + [HGRN_WIDTH] * 3).tolist()
    rq, rk, rv, rg, hq, hf, hi, hg = jnp.split(proj, splits, axis=-1)
    rq = rope(rq.reshape(b, s, RET_HEADS, RET_HEAD_DIM)) * (RET_HEAD_DIM ** -0.5)
    rk = rope(rk.reshape(b, s, RET_HEADS, RET_HEAD_DIM))
    ret = retention_chunkwise(rq, rk, rv.reshape(b, s, RET_HEADS, RET_HEAD_DIM))
    mu = jnp.mean(ret, axis=-1, keepdims=True)
    var = jnp.mean(jnp.square(ret - mu), axis=-1, keepdims=True)
    ret = ((ret - mu) * lax.rsqrt(var + EPS)).reshape(b, s, RET_WIDTH)
    ret = ret * ret_norm_g.astype(jnp.float32) * jax.nn.silu(rg.astype(jnp.float32))
    z = hf.astype(jnp.float32).reshape(b, s, HGRN_HEADS, HGRN_HEAD_DIM)
    lbh = lb.reshape(HGRN_HEADS, HGRN_HEAD_DIM)
    f = lbh + (1.0 - lbh) * jax.nn.sigmoid(z)
    key = (1.0 - lbh) * jax.nn.sigmoid(-z)
    hq_act = jax.nn.silu(hq.astype(jnp.float32)).reshape(b, s, HGRN_HEADS, HGRN_HEAD_DIM)
    hv = hi.reshape(b, s, HGRN_HEADS, HGRN_HEAD_DIM)
    hg_out = hgrn2_chunkwise(hq_act, key, hv, jnp.log(f))
    hg_out = (hg_out * lax.rsqrt(jnp.mean(hg_out * hg_out, axis=-1, keepdims=True) + EPS)).reshape(b, s, HGRN_WIDTH)
    hg_out = hg_out * hgrn_norm_g.astype(jnp.float32) * jax.nn.silu(hg.astype(jnp.float32))
    merged = jnp.concatenate([ret, hg_out], axis=-1).astype(h.dtype)
    return merged @ w_out


def setup_inputs(seed: int = 0) -> dict:
    key = jax.random.key(seed)
    ks = jax.random.split(key, 16)
    f32 = jnp.float32

    def w(k, shape, fan_in):
        return jax.random.normal(k, shape, f32) * (fan_in ** -0.5)

    def gain(k, shape):
        return 1.0 + 0.02 * jax.random.normal(k, shape, f32)

    return {
        "x": jax.random.normal(ks[0], (BATCH, SEQ, D_MODEL), f32),
        "ffn1_norm": gain(ks[1], (DEPTH, D_MODEL)),
        "ffn1_w_gate": w(ks[2], (DEPTH, D_MODEL, D_FF), D_MODEL),
        "ffn1_w_up": w(ks[3], (DEPTH, D_MODEL, D_FF), D_MODEL),
        "ffn1_w_down": w(ks[4], (DEPTH, D_FF, D_MODEL), D_FF),
        "mix_norm": gain(ks[5], (DEPTH, D_MODEL)),
        "w_in": w(ks[6], (DEPTH, D_MODEL, IN_COLS), D_MODEL),
        "ret_norm_g": gain(ks[7], (DEPTH, RET_WIDTH)),
        "hgrn_lb_logits": 0.5 * jax.random.normal(ks[8], (DEPTH, HGRN_WIDTH), f32),
        "hgrn_norm_g": gain(ks[9], (DEPTH, HGRN_WIDTH)),
        "w_out": w(ks[10], (DEPTH, MIX_WIDTH, D_MODEL), MIX_WIDTH),
        "ffn2_norm": gain(ks[11], (DEPTH, D_MODEL)),
        "ffn2_w_gate": w(ks[12], (DEPTH, D_MODEL, D_FF), D_MODEL),
        "ffn2_w_up": w(ks[13], (DEPTH, D_MODEL, D_FF), D_MODEL),
        "ffn2_w_down": w(ks[14], (DEPTH, D_FF, D_MODEL), D_FF),
        "final_norm": gain(ks[15], (D_MODEL,)),
    }


def reference(x, ffn1_norm, ffn1_w_gate, ffn1_w_up, ffn1_w_down, mix_norm, w_in, ret_norm_g,
              hgrn_lb_logits, hgrn_norm_g, w_out, ffn2_norm, ffn2_w_gate, ffn2_w_up, ffn2_w_down, final_norm):
    lbs = hgrn_lower_bounds(hgrn_lb_logits)
    for l in range(DEPTH):
        y = swiglu(rmsnorm(x, ffn1_norm[l]), ffn1_w_gate[l], ffn1_w_up[l], ffn1_w_down[l])
        x = x + (FFN_RESIDUAL_WEIGHT * y).astype(x.dtype)
        y = hybrid_mixer(rmsnorm(x, mix_norm[l]), w_in[l], ret_norm_g[l], lbs[l], hgrn_norm_g[l], w_out[l])
        x = x + y.astype(x.dtype)
        y = swiglu(rmsnorm(x, ffn2_norm[l]), ffn2_w_gate[l], ffn2_w_up[l], ffn2_w_down[l])
        x = x + (FFN_RESIDUAL_WEIGHT * y).astype(x.dtype)
    return rmsnorm(x, final_norm)
```

```cpp
#include <hip/hip_runtime.h>
#include <hip/hip_cooperative_groups.h>
#include <cstdio>
#include <cstdint>
namespace cg = cooperative_groups;

#define MK_LASTP 10
#define MK_SKIP 0
#define PG8_ALIGN 1
#ifndef MK_DUP
#define MK_DUP -1
#endif
#ifndef MK_PER_PHASE
#define MK_PER_PHASE 0
#endif

#define LAS __attribute__((address_space(3)))
#define DI __device__ __forceinline__
typedef unsigned short bf16_t;
typedef short bf16x8 __attribute__((ext_vector_type(8)));
typedef short s16x4 __attribute__((ext_vector_type(4)));
typedef float f32x4 __attribute__((ext_vector_type(4)));
typedef unsigned u32x4 __attribute__((ext_vector_type(4)));
typedef unsigned u32x2 __attribute__((ext_vector_type(2)));

constexpr int SEQ = 8192, M = 16384, D = 2048, FF = 5632, NIN = 8192;
constexpr int PP = NIN + 64;
constexpr float EPS = 1e-6f;
constexpr int COL_RQ = 0, COL_HQ = 1024, COL_RK = 2048, COL_RV = 3072, COL_RG = 4096, COL_HF = 5120, COL_HI = 6144, COL_HG = 7168;
constexpr size_t MiB = 1u << 20;
constexpr size_t WS_SS1 = 0, WS_SS2 = 64 * 1024, WS_SS3 = 128 * 1024;
constexpr size_t WS_BAR = 256 * 1024;
constexpr size_t WS_DEC = 1 * MiB;
constexpr size_t WS_WGU = 2 * MiB, WS_WD = 46 * MiB, WS_WIN = 68 * MiB, WS_WOUT = 100 * MiB;
constexpr size_t WS_XN = 108 * MiB;
constexpr size_t WS_RS = 108 * MiB;
constexpr size_t WS_PROJ = 172 * MiB;
constexpr size_t WS_H = 172 * MiB;
constexpr size_t WS_HS = 432 * MiB;
constexpr size_t WS_END = 496 * MiB;
constexpr int LDS_BYTES = 147456, LDS_MISC = 143360;
constexpr int NWAVES = 8, NTHR = 512;

typedef float f32x2_t __attribute__((ext_vector_type(2)));
typedef __bf16 bf16x2_t __attribute__((ext_vector_type(2)));
DI unsigned cvt_pk_bf16(float lo, float hi) { const f32x2_t v = {lo, hi}; return __builtin_bit_cast(unsigned, __builtin_convertvector(v, bf16x2_t)); }
DI float bf2f(unsigned short v) { return __uint_as_float(((unsigned)v) << 16); }
DI float bflo(unsigned w) { return __uint_as_float(w << 16); }
DI float bfhi(unsigned w) { return __uint_as_float(w & 0xffff0000u); }
DI float siluf(float x) { return x * __builtin_amdgcn_rcpf(1.f + __expf(-x)); }
DI size_t blk_off(int row, int col, int ntK) { return ((size_t)((row >> 8) * ntK + (col >> 6)) << 14) + (size_t)(((row & 255) << 6) + (col & 63)); }
DI float wave_sum(float v) {
#pragma unroll
    for (int o = 1; o < 64; o <<= 1) v += __shfl_xor(v, o);
    return v;
}

namespace pg8 {
constexpr int BM = 256, BK = 64, HALF = 128, HTB = HALF * BK * 2, STAGE_BYTES = 8 * HTB, NXCD = 8, WGM = 4;
__host__ __device__ __forceinline__ int lds_byte(int r, int c) { const int st = (r >> 4) * 2 + (c >> 5), rr = r & 15, cc = c & 31, ob = rr * 64 + cc * 2; return st * 1024 + (ob ^ (((ob >> 9) & 1) << 5)); }
__host__ __device__ __forceinline__ void stage_rc(int b, int& R, int& C) { const int st = b / 1024, sb = b % 1024, swz = sb ^ (((sb >> 9) & 1) << 5); R = (st >> 1) * 16 + swz / 64; C = (st & 1) * 32 + (swz % 64) / 2; }
__host__ __device__ __forceinline__ int perm32(int rho) { const int n = rho >> 4, i = rho & 15; return 8 * (i >> 2) + 4 * n + (i & 3); }
struct Unit { int pm, pn; };
struct Gemm { const bf16_t* A; const bf16_t* Bt; int M, N, K, lda; };
struct StaticOrder {
    int nM, nN, nwg, G, c;
    __device__ void init(int M_, int N_, int G_, int c_) { nM = M_ / BM; nN = N_ / BM; nwg = nM * nN; G = G_; c = c_; }
    __device__ bool next(int i, Unit& u) const {
        const long L = (long)i * G + c; if (L >= nwg) return false;
        int wgid = (int)L; { const int q = nwg / NXCD, r = nwg % NXCD, xcd = wgid % NXCD, off = wgid / NXCD; wgid = (xcd < r ? xcd * (q + 1) : r * (q + 1) + (xcd - r) * q) + off; }
        const int nig = WGM * nN, gid = wgid / nig, fm = gid * WGM, gsz = (nM - fm) < WGM ? (nM - fm) : WGM;
        u.pm = fm + ((wgid % nig) % gsz); u.pn = (wgid % nig) / gsz; return true;
    }
};

struct EpiGateUp {
    static constexpr bool PERM = true;
    bf16_t* H; const float* rowss; bool cheap;
    DI void operator()(const f32x4 (&acc)[2][2][4][2], const Unit& u, int wr, int wc, int fr, int fq) const {
        const int row0 = u.pm * BM + wr * 64 + fr, col0 = u.pn * HALF + wc * 32 + 8 * fq;
        float rsv[2][4];
#pragma unroll
        for (int ai = 0; ai < 2; ++ai)
#pragma unroll
            for (int m = 0; m < 4; ++m) rsv[ai][m] = rowss ? rowss[row0 + ai * HALF + m * 16] : 0.f;
        __builtin_amdgcn_sched_barrier(0);
#pragma unroll
        for (int ai = 0; ai < 2; ++ai)
#pragma unroll
            for (int m = 0; m < 4; ++m) {
                const int row = row0 + ai * HALF + m * 16;
                float rs = 1.f; if (rowss) rs = __builtin_amdgcn_rsqf(rsv[ai][m] * (1.f / D) + EPS);
                float h[8];
#pragma unroll
                for (int n = 0; n < 2; ++n)
#pragma unroll
                    for (int i = 0; i < 4; ++i) { const float g = acc[ai][0][m][n][i] * rs, up = acc[ai][1][m][n][i] * rs; h[4 * n + i] = cheap ? g + up : siluf(g) * up; }
                u32x4 w; w.x = cvt_pk_bf16(h[0], h[1]); w.y = cvt_pk_bf16(h[2], h[3]); w.z = cvt_pk_bf16(h[4], h[5]); w.w = cvt_pk_bf16(h[6], h[7]);
                *(u32x4*)(H + blk_off(row, col0, FF / 64)) = w;
            }
    }
};
struct EpiResid {
    static constexpr bool PERM = false;
    const float* base; float* out; float alpha; const float* gnext; bf16_t* XN; float* rowss;
    DI void operator()(const f32x4 (&acc)[2][2][4][2], const Unit& u, int wr, int wc, int fr, int fq) const {
        const int row0 = u.pm * BM + wr * 64 + fr, col0 = u.pn * BM + wc * 32 + 4 * fq;
        f32x4 gv[2][2];
#pragma unroll
        for (int bj = 0; bj < 2; ++bj)
#pragma unroll
            for (int n = 0; n < 2; ++n) gv[bj][n] = gnext ? *(const f32x4*)(gnext + col0 + bj * HALF + n * 16) : (f32x4){1.f, 1.f, 1.f, 1.f};
#pragma unroll
        for (int ai = 0; ai < 2; ++ai) {
            f32x4 bv[4][2][2];
#pragma unroll
            for (int m = 0; m < 4; ++m)
#pragma unroll
                for (int bj = 0; bj < 2; ++bj)
#pragma unroll
                    for (int n = 0; n < 2; ++n) bv[m][bj][n] = *(const f32x4*)(base + (size_t)(row0 + ai * HALF + m * 16) * D + col0 + bj * HALF + n * 16);
            __builtin_amdgcn_sched_barrier(0);
#pragma unroll
            for (int m = 0; m < 4; ++m) {
                const int row = row0 + ai * HALF + m * 16; const size_t off = (size_t)row * D + col0; float ss = 0.f;
#pragma unroll
                for (int bj = 0; bj < 2; ++bj)
#pragma unroll
                    for (int n = 0; n < 2; ++n) {
                        const f32x4 v = bv[m][bj][n] + acc[ai][bj][m][n] * alpha;
                        *(f32x4*)(out + off + bj * HALF + n * 16) = v;
                        ss += (v[0] * v[0] + v[1] * v[1]) + (v[2] * v[2] + v[3] * v[3]);
                        if (XN) { const f32x4 t = v * gv[bj][n]; u32x2 w; w.x = cvt_pk_bf16(t[0], t[1]); w.y = cvt_pk_bf16(t[2], t[3]); *(u32x2*)(XN + blk_off(row, col0 + bj * HALF + n * 16, D / 64)) = w; }
                    }
                ss += __shfl_xor(ss, 16); ss += __shfl_xor(ss, 32);
                if (rowss && fq == 0) atomicAdd(rowss + row, ss);
            }
            __builtin_amdgcn_sched_barrier(0);
        }
    }
};
struct EpiProj {
    static constexpr bool PERM = true;
    bf16_t* P; const float* rowss;
    DI void operator()(const f32x4 (&acc)[2][2][4][2], const Unit& u, int wr, int wc, int fr, int fq) const {
        const int row0 = u.pm * BM + wr * 64 + fr, col0 = u.pn * BM + wc * 32 + 8 * fq, type = u.pn >> 2;
        float rsv[2][4];
#pragma unroll
        for (int ai = 0; ai < 2; ++ai)
#pragma unroll
            for (int m = 0; m < 4; ++m) rsv[ai][m] = rowss[row0 + ai * HALF + m * 16];
        __builtin_amdgcn_sched_barrier(0);
        if (type == 0 || type == 2) {
            const float qs = (type == 0) ? 0.0625f : 1.f;
            float invf[8];
#pragma unroll
            for (int j = 0; j < 8; ++j) invf[j] = exp2f(-(float)(wc * 32 + 8 * fq + j) * (13.287712379549449f / 128.f));
#pragma unroll
            for (int ai = 0; ai < 2; ++ai)
#pragma unroll
                for (int m = 0; m < 4; ++m) {
                    const int row = row0 + ai * HALF + m * 16; const float rs = __builtin_amdgcn_rsqf(rsv[ai][m] * (1.f / D) + EPS) * qs;
                    const float pos = (float)(row & (SEQ - 1));
                    float o1[8], o2[8];
#pragma unroll
                    for (int n = 0; n < 2; ++n)
#pragma unroll
                        for (int i = 0; i < 4; ++i) {
                            const float ang = pos * invf[4 * n + i]; const float rev = __builtin_amdgcn_fractf(ang * 0.15915494309189535f);
                            const float sn = __builtin_amdgcn_sinf(rev), cs = __builtin_amdgcn_cosf(rev);
                            const float x1 = acc[ai][0][m][n][i] * rs, x2 = acc[ai][1][m][n][i] * rs;
                            o1[4 * n + i] = x1 * cs - x2 * sn; o2[4 * n + i] = x2 * cs + x1 * sn;
                        }
                    u32x4 w; w.x = cvt_pk_bf16(o1[0], o1[1]); w.y = cvt_pk_bf16(o1[2], o1[3]); w.z = cvt_pk_bf16(o1[4], o1[5]); w.w = cvt_pk_bf16(o1[6], o1[7]);
                    *(u32x4*)(P + (size_t)row * PP + col0) = w;
                    w.x = cvt_pk_bf16(o2[0], o2[1]); w.y = cvt_pk_bf16(o2[2], o2[3]); w.z = cvt_pk_bf16(o2[4], o2[5]); w.w = cvt_pk_bf16(o2[6], o2[7]);
                    *(u32x4*)(P + (size_t)row * PP + col0 + HALF) = w;
                }
        } else {
            const bool act = (type == 1 || type == 4 || type == 7);
#pragma unroll
            for (int ai = 0; ai < 2; ++ai)
#pragma unroll
                for (int m = 0; m < 4; ++m) {
                    const int row = row0 + ai * HALF + m * 16; const float rs = __builtin_amdgcn_rsqf(rsv[ai][m] * (1.f / D) + EPS);
#pragma unroll
                    for (int bj = 0; bj < 2; ++bj) {
                        float v[8];
#pragma unroll
                        for (int n = 0; n < 2; ++n)
#pragma unroll
                            for (int i = 0; i < 4; ++i) { const float x = acc[ai][bj][m][n][i] * rs; v[4 * n + i] = act ? siluf(x) : x; }
                        u32x4 w; w.x = cvt_pk_bf16(v[0], v[1]); w.y = cvt_pk_bf16(v[2], v[3]); w.z = cvt_pk_bf16(v[4], v[5]); w.w = cvt_pk_bf16(v[6], v[7]);
                        *(u32x4*)(P + (size_t)row * PP + col0 + bj * HALF) = w;
                    }
                }
        }
    }
};

template <class Epi>
DI void gemm_phase(LAS unsigned char* lds, const Gemm g, const StaticOrder& S, const Epi& E) {
    const int tid = threadIdx.x, wid = __builtin_amdgcn_readfirstlane(tid >> 6), lane = tid & 63, wr = wid >> 2, wc = wid & 3, fr = lane & 15, fq = lane >> 4;
    const int K = g.K, nt = K / BK, lda = g.lda; const bool ablk = (lda == 0);
    unsigned voffA[2], voffB[2];
#pragma unroll
    for (int i = 0; i < 2; ++i) { int R, C; stage_rc(tid * 16 + i * 8192, R, C); const int Rb = Epi::PERM ? ((R & ~31) + perm32(R & 31)) : R;
        voffA[i] = ablk ? (unsigned)(R * 64 + C) * 2u : (unsigned)(R * lda + C) * 2u; voffB[i] = (unsigned)(Rb * 64 + C) * 2u; }
    const size_t kstepB = 32768, kstepA = ablk ? (size_t)32768 : (size_t)(BK * 2);
    const size_t hstepB = 16384, hstepA = ablk ? (size_t)16384 : (size_t)HALF * lda * 2;
    const size_t tstepB = (size_t)nt * 32768, tstepA = ablk ? (size_t)nt * 32768 : 2 * hstepA;
    const unsigned ldsw = (unsigned)wid * 1024u;
    const int aoff = lds_byte(wr * 64 + fr, fq * 8), boff = lds_byte(wc * 32 + fr, fq * 8);
#define PG8_SA(b, h) (((b) * 2 + (h)) * HTB)
#define PG8_SB(b, h) ((4 + (b) * 2 + (h)) * HTB)
#define PG8_STAGE(bufoff, gbase, voff) do { _Pragma("unroll") for (int _i = 0; _i < 2; ++_i) \
        __builtin_amdgcn_global_load_lds((const unsigned*)((const char*)(gbase) + (voff)[_i]), (LAS unsigned*)(lds + (bufoff) + ldsw + _i * 8192), 16, 0, 0); } while (0)
#define PG8_LDA(dst, b, h) do { _Pragma("unroll") for (int m = 0; m < 4; ++m) _Pragma("unroll") for (int k = 0; k < 2; ++k) dst[m][k] = *(const LAS bf16x8*)(lds + PG8_SA(b, h) + aoff + m * 2048 + k * 1024); } while (0)
#define PG8_LDB(dst, b, h) do { _Pragma("unroll") for (int n = 0; n < 2; ++n) _Pragma("unroll") for (int k = 0; k < 2; ++k) dst[n][k] = *(const LAS bf16x8*)(lds + PG8_SB(b, h) + boff + n * 2048 + k * 1024); } while (0)
#define PG8_MMA(ai, bj, At, Bt) do { __builtin_amdgcn_s_setprio(1); _Pragma("unroll") for (int m = 0; m < 4; ++m) _Pragma("unroll") for (int n = 0; n < 2; ++n) _Pragma("unroll") for (int k = 0; k < 2; ++k) \
        acc[ai][bj][m][n] = __builtin_amdgcn_mfma_f32_16x16x32_bf16(Bt[n][k], At[m][k], acc[ai][bj][m][n], 0, 0, 0); __builtin_amdgcn_s_setprio(0); } while (0)
#define PG8_WAIT_V(n) asm volatile("s_waitcnt vmcnt(" #n ")" ::: "memory")
#define PG8_WAIT_L(n) asm volatile("s_waitcnt lgkmcnt(" #n ")" ::: "memory")
#define PG8_BAR __builtin_amdgcn_s_barrier()
#define PG8_SCHED __builtin_amdgcn_sched_barrier(0)
    Unit cur, nxt; int ui = 0;
    if (!S.next(0, cur)) return;
    f32x4 acc[2][2][4][2];
#pragma unroll
    for (int a = 0; a < 2; ++a)
#pragma unroll
        for (int b = 0; b < 2; ++b)
#pragma unroll
            for (int m = 0; m < 4; ++m)
#pragma unroll
                for (int n = 0; n < 2; ++n) acc[a][b][m][n] = (f32x4){0.f, 0.f, 0.f, 0.f};
    bf16x8 At[4][2], B0[2][2], B1[2][2];
    const char* cA = (const char*)g.A + (size_t)cur.pm * tstepA; const char* cB = (const char*)g.Bt + (size_t)cur.pn * tstepB;
    PG8_STAGE(PG8_SB(0, 0), cB, voffB); PG8_STAGE(PG8_SB(0, 1), cB + hstepB, voffB); PG8_STAGE(PG8_SA(0, 0), cA, voffA); PG8_STAGE(PG8_SA(0, 1), cA + hstepA, voffA);
    if (wr == 1) PG8_BAR;
    PG8_WAIT_V(2); PG8_BAR;
    PG8_STAGE(PG8_SB(1, 0), cB + kstepB, voffB); PG8_STAGE(PG8_SA(1, 0), cA + kstepA, voffA); PG8_STAGE(PG8_SB(1, 1), cB + hstepB + kstepB, voffB);
    PG8_WAIT_V(6); PG8_BAR;
    for (;;) {
        const bool has_next = S.next(ui + 1, nxt);
        const char* nA = has_next ? (const char*)g.A + (size_t)nxt.pm * tstepA : cA; const char* nB = has_next ? (const char*)g.Bt + (size_t)nxt.pn * tstepB : cB;
        for (int t = 0; t < nt; t += 2) {
            const bool last = (t == nt - 2);
            const char* a1 = cA + (size_t)(t + 1) * kstepA;
            const char* a2 = last ? nA : cA + (size_t)(t + 2) * kstepA; const char* b2 = last ? nB : cB + (size_t)(t + 2) * kstepB;
            const char* a3 = a2 + kstepA; const char* b3 = b2 + kstepB;
            PG8_LDB(B0, 0, 0); PG8_LDB(B1, 0, 1); PG8_SCHED; PG8_LDA(At, 0, 0); PG8_STAGE(PG8_SA(1, 1), a1 + hstepA, voffA);
            PG8_WAIT_V(8); PG8_WAIT_L(0); PG8_BAR; PG8_MMA(0, 0, At, B0); PG8_MMA(0, 1, At, B1); PG8_BAR; PG8_SCHED;
            PG8_LDA(At, 0, 1); PG8_STAGE(PG8_SB(0, 0), b2, voffB); PG8_STAGE(PG8_SB(0, 1), b2 + hstepB, voffB); PG8_STAGE(PG8_SA(0, 0), a2, voffA);
            PG8_WAIT_V(8); PG8_WAIT_L(0); PG8_BAR; PG8_MMA(1, 0, At, B0); PG8_MMA(1, 1, At, B1); PG8_BAR; PG8_SCHED;
            PG8_LDB(B0, 1, 0); PG8_LDB(B1, 1, 1); PG8_SCHED; PG8_LDA(At, 1, 0); PG8_STAGE(PG8_SA(0, 1), a2 + hstepA, voffA);
            PG8_WAIT_V(8); PG8_WAIT_L(0); PG8_BAR; PG8_MMA(0, 0, At, B0); PG8_MMA(0, 1, At, B1); PG8_BAR; PG8_SCHED;
            PG8_LDA(At, 1, 1); PG8_STAGE(PG8_SB(1, 0), b3, voffB); PG8_STAGE(PG8_SB(1, 1), b3 + hstepB, voffB); PG8_STAGE(PG8_SA(1, 0), a3, voffA);
            PG8_WAIT_V(8); PG8_WAIT_L(0); PG8_BAR; PG8_MMA(1, 0, At, B0); PG8_MMA(1, 1, At, B1); PG8_BAR; PG8_SCHED;
        }
#if PG8_ALIGN
        if (wr == 0) PG8_BAR;
#endif
        E(acc, cur, wr, wc, fr, fq);
        if (!has_next) break;
#pragma unroll
        for (int a = 0; a < 2; ++a)
#pragma unroll
            for (int b = 0; b < 2; ++b)
#pragma unroll
                for (int m = 0; m < 4; ++m)
#pragma unroll
                    for (int n = 0; n < 2; ++n) acc[a][b][m][n] = (f32x4){0.f, 0.f, 0.f, 0.f};
        cur = nxt; cA = nA; cB = nB; ++ui;
#if PG8_ALIGN
        if (wr == 1) PG8_BAR;
#endif
    }
    PG8_WAIT_V(0);
#if !PG8_ALIGN
    if (wr == 0) PG8_BAR;
#endif
    PG8_BAR;
#undef PG8_SA
#undef PG8_SB
#undef PG8_STAGE
#undef PG8_LDA
#undef PG8_LDB
#undef PG8_MMA
#undef PG8_WAIT_V
#undef PG8_WAIT_L
#undef PG8_BAR
#undef PG8_SCHED
}
}

#define MF(a, b, c) __builtin_amdgcn_mfma_f32_16x16x32_bf16((a), (b), (c), 0, 0, 0)
DI bf16x8 frag_nat(const LAS short* img, int stride, int row0, int k0, int fr, int fq) { return *(const LAS bf16x8*)(img + (row0 + fr) * stride + k0 + 8 * fq); }
DI bf16x8 frag_tr(const LAS short* img, int stride, int k0r, int col0, int fr, int fq) {
    const LAS short* p = img + (k0r + 8 * fq + (fr >> 2)) * stride + col0 + 4 * (fr & 3);
    const s16x4 lo = __builtin_amdgcn_ds_read_tr16_b64_v4i16((LAS s16x4*)p);
    const s16x4 hi = __builtin_amdgcn_ds_read_tr16_b64_v4i16((LAS s16x4*)(p + 4 * stride));
    return __builtin_shufflevector(lo, hi, 0, 1, 2, 3, 4, 5, 6, 7);
}
DI bf16x8 frag_glb(const bf16_t* g, int stride, int row0, int k0, int fr, int fq) { return *(const bf16x8*)(g + (size_t)(row0 + fr) * stride + k0 + 8 * fq); }


#define XB_TMO      128
#define XB_XCNT(j)  (256  + 64 * (j))
#define XB_XSUB(j)  (1280 + 64 * (j))
#define XB_XGEN(j)  (2304 + 64 * (j))
#define XB_TOP      3328
#define XB_TOPGEN   3392
#define XCD_BAR_WORDS 3456
#define XB_SPIN_CAP (1u << 22)
DI unsigned xb_ld(unsigned* p)              { return __hip_atomic_load(p, __ATOMIC_RELAXED, __HIP_MEMORY_SCOPE_AGENT); }
DI unsigned xb_add(unsigned* p, unsigned v) { return __hip_atomic_fetch_add(p, v, __ATOMIC_RELAXED, __HIP_MEMORY_SCOPE_AGENT); }
DI unsigned xb_xcc_id() { return (unsigned)__builtin_amdgcn_s_getreg((3 << 11) | 20) & 0xFu; }
#define XB_SPIN(cond, bar) do { unsigned _sp = 0; while (cond) { __builtin_amdgcn_s_sleep(1); \
    if ((++_sp & 255u) == 0u) { if (xb_ld(&(bar)[XB_TMO])) break; if (_sp > XB_SPIN_CAP) { atomicAdd(&(bar)[XB_TMO], 1u); break; } } } } while (0)
struct XcdBarrier { unsigned* bar; unsigned x; volatile LAS unsigned* st; };
DI XcdBarrier xcd_barrier_post(unsigned* bar, volatile LAS unsigned* st) {
    XcdBarrier b; b.bar = bar; b.x = xb_xcc_id(); b.st = st;
    if (threadIdx.x == 0) (void)xb_add(&bar[XB_XCNT(b.x)], 1u);
    return b;
}
DI void xcd_barrier_complete(unsigned* bar, unsigned x, unsigned& nloc, unsigned& nx) {
    const unsigned G = gridDim.x * gridDim.y * gridDim.z;
    unsigned sum, cnt, mine, sp = 0u;
    for (;;) {
        sum = 0u; cnt = 0u; mine = 0u;
#pragma unroll
        for (unsigned j = 0; j < 16; ++j) { const unsigned c = xb_ld(&bar[XB_XCNT(j)]); sum += c; cnt += (c > 0u) ? 1u : 0u; mine = (j == x) ? c : mine; }
        if (sum == G) break;
        __builtin_amdgcn_s_sleep(1);
        if ((++sp & 255u) == 0u) { if (xb_ld(&bar[XB_TMO])) break; if (sp > XB_SPIN_CAP) { atomicAdd(&bar[XB_TMO], 1u); break; } }
    }
    nloc = mine > 0u ? mine : 1u; nx = cnt > 0u ? cnt : 1u;
}
DI void xcd_barrier(const XcdBarrier& b) {
    asm volatile("s_waitcnt vmcnt(0)" ::: "memory");
    __syncthreads();
    if (threadIdx.x == 0) {
        unsigned* bar = b.bar;
        __builtin_amdgcn_s_waitcnt(0);
        unsigned nloc = b.st[0], nx = b.st[1];
        if (nloc == 0u) { xcd_barrier_complete(bar, b.x, nloc, nx); b.st[0] = nloc; b.st[1] = nx; }
        const unsigned old = xb_add(&bar[XB_XSUB(b.x)], 1u);
        const unsigned gen = old / nloc;
        if (old + 1u == (gen + 1u) * nloc) {
            __builtin_amdgcn_fence(__ATOMIC_RELEASE, "agent");
            asm volatile("s_waitcnt vmcnt(0)" ::: "memory");
            const unsigned og = xb_add(&bar[XB_TOP], 1u);
            const unsigned tg = og / nx;
            if (og + 1u == (tg + 1u) * nx) xb_add(&bar[XB_TOPGEN], 1u);
            else XB_SPIN(xb_ld(&bar[XB_TOPGEN]) == tg, bar);
            __builtin_amdgcn_fence(__ATOMIC_ACQUIRE, "agent");
            xb_add(&bar[XB_XGEN(b.x)], 1u);
            asm volatile("s_waitcnt vmcnt(0)" ::: "memory");
        } else {
            XB_SPIN(xb_ld(&bar[XB_XGEN(b.x)]) == gen, bar);
            __builtin_amdgcn_fence(__ATOMIC_ACQUIRE, "agent");
            asm volatile("s_waitcnt vmcnt(0)" ::: "memory");
        }
    }
    __syncthreads();
}

struct Ctx {
    const float* in[16]; float* out; unsigned char* ws;
    int tid, lane, wave, G, bx;
};

DI void transpose_item(const float* W, int K, int N, bf16_t* WT, int k0, int n0, int drow0, LAS float* scr, int lane) {
    float wv[32];
#pragma unroll
    for (int i = 0; i < 32; ++i) wv[i] = W[(size_t)(k0 + 2 * i + (lane >> 5)) * N + n0 + (lane & 31)];
    __builtin_amdgcn_sched_barrier(0);
#pragma unroll
    for (int i = 0; i < 32; ++i) scr[(2 * i + (lane >> 5)) * 33 + (lane & 31)] = wv[i];
    asm volatile("s_waitcnt lgkmcnt(0)" ::: "memory");
    const int c = lane & 7;
#pragma unroll
    for (int j = 0; j < 4; ++j) { const int n = (lane >> 3) + 8 * j; const LAS float* s = scr + (8 * c) * 33 + n;
        u32x4 o; o.x = cvt_pk_bf16(s[0 * 33], s[1 * 33]); o.y = cvt_pk_bf16(s[2 * 33], s[3 * 33]); o.z = cvt_pk_bf16(s[4 * 33], s[5 * 33]); o.w = cvt_pk_bf16(s[6 * 33], s[7 * 33]);
        *(u32x4*)(WT + blk_off(drow0 + n, k0 + 8 * c, K / 64)) = o; }
    asm volatile("s_waitcnt lgkmcnt(0)" ::: "memory");
}
DI void convert_ffn_item(int it, const float* Wg, const float* Wu, const float* Wd, bf16_t* WGU, bf16_t* WDt, LAS float* scr, int lane) {
    constexpr int NB = FF / 32;
    if (it < 2 * 5632) {
        const bool up = it >= 5632; const int r = up ? it - 5632 : it; const int kb = r / NB, nb = r % NB, n0 = nb * 32;
        const int drow = (n0 >> 7) * 256 + (n0 & 127) + (up ? 128 : 0);
        transpose_item(up ? Wu : Wg, D, FF, WGU, kb * 64, n0, drow, scr, lane);
    } else {
        const int r = it - 2 * 5632; const int kb = r / (D / 32), nb = r % (D / 32);
        transpose_item(Wd, FF, D, WDt, kb * 64, nb * 32, nb * 32, scr, lane);
    }
}
DI int win_perm_seg(int s) { return s == 0 ? 0 : s == 1 ? 2 : s == 2 ? 3 : s == 3 ? 4 : s == 4 ? 1 : s; }

DI void phase_prologue(Ctx& C, LAS unsigned char* lds) {
    LAS float* scr = (LAS float*)(lds + C.wave * 16384);
    const int gw = C.bx * NWAVES + C.wave, NGW = C.G * NWAVES;
    bf16_t* WGU = (bf16_t*)(C.ws + WS_WGU); bf16_t* WDt = (bf16_t*)(C.ws + WS_WD); bf16_t* WIN = (bf16_t*)(C.ws + WS_WIN); bf16_t* WOUT = (bf16_t*)(C.ws + WS_WOUT);
    constexpr int I_FFN = 3 * 5632, I_IN = 32 * 256, I_OUT = 32 * 64;
    for (int it = gw; it < I_FFN + I_IN + I_OUT; it += NGW) {
        if (it < I_FFN) { convert_ffn_item(it, C.in[2], C.in[3], C.in[4], WGU, WDt, scr, C.lane); continue; }
        int r = it - I_FFN;
        if (r < I_IN) { const int kb = r / 256, nb = r % 256, n0 = nb * 32; const int drow = win_perm_seg(n0 >> 10) * 1024 + (n0 & 1023);
            transpose_item(C.in[6], D, NIN, WIN, kb * 64, n0, drow, scr, C.lane); continue; }
        r -= I_IN; { const int kb = r / 64, nb = r % 64; transpose_item(C.in[10], D, D, WOUT, kb * 64, nb * 32, nb * 32, scr, C.lane); }
    }
    const float* g1 = C.in[1]; bf16_t* XN = (bf16_t*)(C.ws + WS_XN);
    f32x4 g1v[8];
#pragma unroll
    for (int j = 0; j < 8; ++j) g1v[j] = *((const f32x4*)g1 + 64 * j + C.lane);
    {
        f32x4 v[8], nv[8];
        if (gw < M) {
#pragma unroll
            for (int j = 0; j < 8; ++j) v[j] = *((const f32x4*)(C.in[0] + (size_t)gw * D) + C.lane + 64 * j);
        }
        for (int m = gw; m < M; m += NGW) {
            const int mn = (m + NGW < M) ? m + NGW : m;
#pragma unroll
            for (int j = 0; j < 8; ++j) nv[j] = *((const f32x4*)(C.in[0] + (size_t)mn * D) + C.lane + 64 * j);
            __builtin_amdgcn_sched_barrier(0);
            float s = 0.f;
#pragma unroll
            for (int j = 0; j < 8; ++j) s += (v[j][0] * v[j][0] + v[j][1] * v[j][1]) + (v[j][2] * v[j][2] + v[j][3] * v[j][3]);
            const float rs = 1.f / sqrtf(wave_sum(s) * (1.f / D) + EPS);
#pragma unroll
            for (int j = 0; j < 8; ++j) { const f32x4 gg = g1v[j]; u32x2 w; w.x = cvt_pk_bf16(v[j][0] * rs * gg[0], v[j][1] * rs * gg[1]); w.y = cvt_pk_bf16(v[j][2] * rs * gg[2], v[j][3] * rs * gg[3]); *(u32x2*)(XN + blk_off(m, 4 * (64 * j + C.lane), D / 64)) = w; }
            __builtin_amdgcn_sched_barrier(0);
#pragma unroll
            for (int j = 0; j < 8; ++j) v[j] = nv[j];
        }
    }
    float* ssb = (float*)(C.ws + WS_SS1);
    for (int i = C.bx * NTHR + C.tid; i < 3 * M; i += C.G * NTHR) ssb[i] = 0.f;
}

DI void ret_pass_a(Ctx& C, LAS unsigned char* lds, int unit) {
    const bf16_t* P = (const bf16_t*)(C.ws + WS_PROJ); bf16_t* RS = (bf16_t*)(C.ws + WS_RS) + (size_t)unit * 65536;
    int tid_l = threadIdx.x; asm volatile("" : "+v"(tid_l));
    const int lane_l = tid_l & 63;
    const int h = unit & 3, bn = unit >> 2, row0 = bn * 128, fr = lane_l & 15, fq = lane_l >> 4, w = C.wave;
    LAS short* Vi = (LAS short*)lds; LAS short* Ki = Vi + 128 * 264;
    const float lg = __logf(1.f - exp2f(-5.f - (float)h));
    u32x4 kst[8], vst[8];
#pragma unroll
    for (int it = 0; it < 8; ++it) { const int c = it * NTHR + tid_l, r = c >> 5, ch = c & 31; const bf16_t* src = P + (size_t)(row0 + r) * PP + h * 256 + ch * 8;
        vst[it] = *(const u32x4*)(src + COL_RV); kst[it] = *(const u32x4*)(src + COL_RK); }
#pragma unroll
    for (int it = 0; it < 8; ++it) {
        const int c = it * NTHR + tid_l, r = c >> 5, ch = c & 31;
        const u32x4 vv = vst[it]; const u32x4 kk = kst[it];
        const float dc = __expf(lg * (float)(127 - r));
        u32x4 ko; ko.x = cvt_pk_bf16(bflo(kk.x) * dc, bfhi(kk.x) * dc); ko.y = cvt_pk_bf16(bflo(kk.y) * dc, bfhi(kk.y) * dc); ko.z = cvt_pk_bf16(bflo(kk.z) * dc, bfhi(kk.z) * dc); ko.w = cvt_pk_bf16(bflo(kk.w) * dc, bfhi(kk.w) * dc);
        *(LAS u32x4*)(Vi + r * 264 + ch * 8) = vv; *(LAS u32x4*)(Ki + r * 264 + ch * 8) = ko;
    }
    __syncthreads();
    for (int db = 0; db < 4; ++db) {
        f32x4 acc[2][4];
#pragma unroll
        for (int a = 0; a < 2; ++a)
#pragma unroll
            for (int b = 0; b < 4; ++b) acc[a][b] = (f32x4){0.f, 0.f, 0.f, 0.f};
#pragma unroll
        for (int ks = 0; ks < 4; ++ks) {
            bf16x8 vf[2], kf[4];
#pragma unroll
            for (int et = 0; et < 2; ++et) vf[et] = frag_tr(Vi, 264, 32 * ks, 32 * w + 16 * et, fr, fq);
#pragma unroll
            for (int dt = 0; dt < 4; ++dt) kf[dt] = frag_tr(Ki, 264, 32 * ks, 64 * db + 16 * dt, fr, fq);
            __builtin_amdgcn_sched_barrier(0);
#pragma unroll
            for (int et = 0; et < 2; ++et)
#pragma unroll
                for (int dt = 0; dt < 4; ++dt) acc[et][dt] = MF(kf[dt], vf[et], acc[et][dt]);
        }
#pragma unroll
        for (int et = 0; et < 2; ++et)
#pragma unroll
            for (int dt = 0; dt < 4; ++dt) { u32x2 o; o.x = cvt_pk_bf16(acc[et][dt][0], acc[et][dt][1]); o.y = cvt_pk_bf16(acc[et][dt][2], acc[et][dt][3]);
                *(u32x2*)(RS + (size_t)(32 * w + 16 * et + fr) * 256 + 64 * db + 16 * dt + 4 * fq) = o; }
    }
    __syncthreads();
}

struct HPrep { float cum[16]; float kk[16]; float off, total, cmid; };
DI void hgrn_prep(Ctx& C, LAS float* segtot, const bf16_t* P, int row0, int h, HPrep& hp) {
    const int d = C.tid & 127, seg = C.tid >> 7;
    const float lbl = C.in[8][h * 128 + d]; const float lbv = __builtin_amdgcn_rcpf(1.f + __expf(-lbl)), oml = 1.f - lbv;
    float run = 0.f;
#pragma unroll
    for (int r = 0; r < 16; ++r) {
        float z = bf2f(P[(size_t)(row0 + 16 * seg + r) * PP + COL_HF + h * 128 + d]); z = fminf(fmaxf(z, -30.f), 30.f);
        const float e = __expf(-z), sg = __builtin_amdgcn_rcpf(1.f + e), f = lbv + oml * sg;
        run += __logf(f); hp.cum[r] = run; hp.kk[r] = oml * e * sg;
    }
    segtot[seg * 128 + d] = run;
    __syncthreads();
    const float t0 = segtot[d], t1 = segtot[128 + d], t2 = segtot[256 + d], t3 = segtot[384 + d];
    hp.off = seg == 0 ? 0.f : seg == 1 ? t0 : seg == 2 ? t0 + t1 : t0 + t1 + t2;
    hp.total = (t0 + t1) + (t2 + t3); hp.cmid = t0 + t1;
}
DI void hgrn_pass_a(Ctx& C, LAS unsigned char* lds, int unit) {
    const bf16_t* P = (const bf16_t*)(C.ws + WS_PROJ); bf16_t* HS = (bf16_t*)(C.ws + WS_HS) + (size_t)unit * 16384; float* DEC = (float*)(C.ws + WS_DEC) + (size_t)unit * 128;
    const int h = unit & 7, bn = unit >> 3, row0 = bn * 64, fr = C.lane & 15, fq = C.lane >> 4, w = C.wave;
    LAS short* Vi = (LAS short*)lds; LAS short* Ki = Vi + 64 * 136; LAS float* segtot = (LAS float*)(Ki + 64 * 136);
    const int d = C.tid & 127, seg = C.tid >> 7;
#pragma unroll
    for (int it = 0; it < 2; ++it) { const int c = it * NTHR + C.tid, r = c >> 4, ch = c & 15;
        *(LAS u32x4*)(Vi + r * 136 + ch * 8) = *(const u32x4*)(P + (size_t)(row0 + r) * PP + COL_HI + h * 128 + ch * 8); }
    HPrep hp; hgrn_prep(C, segtot, P, row0, h, hp);
#pragma unroll
    for (int r = 0; r < 16; ++r) { const float c = hp.cum[r] + hp.off; const float kd = hp.kk[r] * __expf(hp.total - c);
        Ki[(16 * seg + r) * 136 + d] = (short)(cvt_pk_bf16(kd, 0.f) & 0xffffu); }
    if (seg == 0) DEC[d] = __expf(hp.total);
    __syncthreads();
    f32x4 acc[8];
#pragma unroll
    for (int b = 0; b < 8; ++b) acc[b] = (f32x4){0.f, 0.f, 0.f, 0.f};
#pragma unroll
    for (int ks = 0; ks < 2; ++ks) {
        const bf16x8 vf = frag_tr(Vi, 136, 32 * ks, 16 * w, fr, fq);
#pragma unroll
        for (int dt = 0; dt < 8; ++dt) { const bf16x8 kf = frag_tr(Ki, 136, 32 * ks, 16 * dt, fr, fq); acc[dt] = MF(kf, vf, acc[dt]); }
    }
#pragma unroll
    for (int dt = 0; dt < 8; ++dt) { u32x2 o; o.x = cvt_pk_bf16(acc[dt][0], acc[dt][1]); o.y = cvt_pk_bf16(acc[dt][2], acc[dt][3]);
        *(u32x2*)(HS + (size_t)(16 * w + fr) * 128 + 16 * dt + 4 * fq) = o; }
    __syncthreads();
}

struct HPrep2 { float cum[32]; float kk[32]; float off, total; };
DI void hgrn_prep2(Ctx& C, LAS float* segtot, const bf16_t* P, int row0, int hp, int tid_l, HPrep2& hp2) {
    const int d2 = tid_l & 255, seg = tid_l >> 8;
    const float lbl = C.in[8][hp * 256 + d2]; const float lbv = __builtin_amdgcn_rcpf(1.f + __expf(-lbl)), oml = 1.f - lbv;
    unsigned short zr[32];
#pragma unroll
    for (int r = 0; r < 32; ++r) zr[r] = P[(size_t)(row0 + 32 * seg + r) * PP + COL_HF + hp * 256 + d2];
    __builtin_amdgcn_sched_barrier(0);
    float run = 0.f;
#pragma unroll
    for (int r = 0; r < 32; ++r) {
        float z = bf2f(zr[r]); z = fminf(fmaxf(z, -30.f), 30.f);
        const float e = __expf(-z), sg = __builtin_amdgcn_rcpf(1.f + e), f = lbv + oml * sg;
        run += __logf(f); hp2.cum[r] = run; hp2.kk[r] = oml * e * sg;
    }
    segtot[seg * 256 + d2] = run;
    __syncthreads();
    const float t0 = segtot[d2], t1 = segtot[256 + d2];
    hp2.off = seg == 0 ? 0.f : t0; hp2.total = t0 + t1;
}
DI void hgrn_pass_a2(Ctx& C, LAS unsigned char* lds, int pu) {
    const bf16_t* P = (const bf16_t*)(C.ws + WS_PROJ);
    int tid_l = threadIdx.x; asm volatile("" : "+v"(tid_l));
    const int lane_l = tid_l & 63, hp = pu & 3, bn = pu >> 2, row0 = bn * 64, fr = lane_l & 15, fq = lane_l >> 4, w = C.wave;
    LAS short* Vi = (LAS short*)lds; LAS short* Ki = Vi + 64 * 264; LAS float* segtot = (LAS float*)(Ki + 64 * 264);
    const int d2 = tid_l & 255, seg = tid_l >> 8;
    u32x4 vst[4];
#pragma unroll
    for (int it = 0; it < 4; ++it) { const int c = it * NTHR + tid_l, r = c >> 5, ch = c & 31; vst[it] = *(const u32x4*)(P + (size_t)(row0 + r) * PP + COL_HI + hp * 256 + ch * 8); }
    HPrep2 h2; hgrn_prep2(C, segtot, P, row0, hp, tid_l, h2);
#pragma unroll
    for (int it = 0; it < 4; ++it) { const int c = it * NTHR + tid_l, r = c >> 5, ch = c & 31; *(LAS u32x4*)(Vi + r * 264 + ch * 8) = vst[it]; }
#pragma unroll
    for (int r = 0; r < 32; ++r) { const float c = h2.cum[r] + h2.off; Ki[(32 * seg + r) * 264 + d2] = (short)(cvt_pk_bf16(h2.kk[r] * __expf(h2.total - c), 0.f) & 0xffffu); }
    if (seg == 0) ((float*)(C.ws + WS_DEC))[(size_t)(bn * 8 + 2 * hp + (d2 >> 7)) * 128 + (d2 & 127)] = __expf(h2.total);
    __syncthreads();
#pragma unroll
    for (int hd = 0; hd < 2; ++hd) {
        bf16_t* HS = (bf16_t*)(C.ws + WS_HS) + (size_t)(bn * 8 + 2 * hp + hd) * 16384;
        f32x4 acc[8];
#pragma unroll
        for (int b = 0; b < 8; ++b) acc[b] = (f32x4){0.f, 0.f, 0.f, 0.f};
#pragma unroll
        for (int ks = 0; ks < 2; ++ks) {
            const bf16x8 vf = frag_tr(Vi, 264, 32 * ks, 128 * hd + 16 * w, fr, fq);
            bf16x8 kf[8];
#pragma unroll
            for (int dt = 0; dt < 8; ++dt) kf[dt] = frag_tr(Ki, 264, 32 * ks, 128 * hd + 16 * dt, fr, fq);
            __builtin_amdgcn_sched_barrier(0);
#pragma unroll
            for (int dt = 0; dt < 8; ++dt) acc[dt] = MF(kf[dt], vf, acc[dt]);
        }
#pragma unroll
        for (int dt = 0; dt < 8; ++dt) { u32x2 o; o.x = cvt_pk_bf16(acc[dt][0], acc[dt][1]); o.y = cvt_pk_bf16(acc[dt][2], acc[dt][3]);
            *(u32x2*)(HS + (size_t)(16 * w + fr) * 128 + 16 * dt + 4 * fq) = o; }
    }
    __syncthreads();
}
template <int SK> DI void hgrn_pass_c2(Ctx& C, LAS unsigned char* lds, int pu) {
    bf16_t* P = (bf16_t*)(C.ws + WS_PROJ);
    int tid_l = threadIdx.x; asm volatile("" : "+v"(tid_l));
    const int lane_l = tid_l & 63, hp = pu & 3, bn = pu >> 2, row0 = bn * 64, fr = lane_l & 15, fq = lane_l >> 4, w = C.wave;
    LAS short* Qt = (LAS short*)lds; LAS short* Kt = Qt + 64 * 264; LAS short* Vi = Kt + 64 * 264;
    LAS float* segtot = (LAS float*)(Vi + 64 * 264); LAS float* ssx = segtot + 512; LAS short* Sw = (LAS short*)(ssx + 256) + w * 16 * 72;
    const int d2 = tid_l & 255, seg = tid_l >> 8;
    const int rb = w & 3, eh = w >> 2, t0 = 16 * rb, trow = t0 + fr;
    u32x4 vst[4];
#pragma unroll
    for (int it = 0; it < 4; ++it) { const int c = it * NTHR + tid_l, r = c >> 5, ch = c & 31; vst[it] = *(const u32x4*)(P + (size_t)(row0 + r) * PP + COL_HI + hp * 256 + ch * 8); }
    unsigned short qr[32];
#pragma unroll
    for (int r = 0; r < 32; ++r) qr[r] = P[(size_t)(row0 + 32 * seg + r) * PP + COL_HQ + hp * 256 + d2];
    u32x2 sgv[2][4];
#pragma unroll
    for (int hd = 0; hd < 2; ++hd)
#pragma unroll
        for (int et = 0; et < 4; ++et) sgv[hd][et] = *(const u32x2*)(P + (size_t)(row0 + trow) * PP + COL_HG + hp * 256 + 128 * hd + 64 * eh + 16 * et + 4 * fq);
    f32x4 ggv[2][4];
#pragma unroll
    for (int hd = 0; hd < 2; ++hd)
#pragma unroll
        for (int et = 0; et < 4; ++et) ggv[hd][et] = *(const f32x4*)(C.in[9] + hp * 256 + 128 * hd + 64 * eh + 16 * et + 4 * fq);
    HPrep2 h2; hgrn_prep2(C, segtot, P, row0, hp, tid_l, h2);
#pragma unroll
    for (int it = 0; it < 4; ++it) { const int c = it * NTHR + tid_l, r = c >> 5, ch = c & 31; *(LAS u32x4*)(Vi + r * 264 + ch * 8) = vst[it]; }
#pragma unroll
    for (int r = 0; r < 32; ++r) {
        const float c = h2.cum[r] + h2.off; const int a = (32 * seg + r) * 264 + d2;
        if (!(SK & 2)) { Qt[a] = (short)(cvt_pk_bf16(bf2f(qr[r]) * __expf(c), 0.f) & 0xffffu);
        Kt[a] = (short)(cvt_pk_bf16(h2.kk[r] * __expf(-c), 0.f) & 0xffffu); }
    }
    __syncthreads();
    f32x4 oo[2][4];
    bf16x8 hsf[4][4];
    {   const bf16_t* HS0 = (const bf16_t*)(C.ws + WS_HS) + (size_t)(bn * 8 + 2 * hp) * 16384;
#pragma unroll
        for (int ks = 0; ks < 4; ++ks)
#pragma unroll
            for (int et = 0; et < 4; ++et) hsf[ks][et] = frag_glb(HS0, 128, 64 * eh + 16 * et, 32 * ks, fr, fq);
        __builtin_amdgcn_sched_barrier(0); }
#pragma unroll
    for (int hd = 0; hd < 2; ++hd) {
        if (SK & 1) { for (int et = 0; et < 4; ++et) oo[hd][et] = (f32x4){1.f, 1.f, 1.f, 1.f}; continue; }
        bf16x8 qf[4];
#pragma unroll
        for (int ks = 0; ks < 4; ++ks) qf[ks] = frag_nat(Qt, 264, t0, 128 * hd + 32 * ks, fr, fq);
#pragma unroll
        for (int jt = 0; jt < 4; ++jt) {
            u32x2 sp = (u32x2){0u, 0u};
            if (jt <= rb) {
                f32x4 a = (f32x4){0.f, 0.f, 0.f, 0.f};
                bf16x8 kf[4];
#pragma unroll
                for (int ks = 0; ks < 4; ++ks) kf[ks] = frag_nat(Kt, 264, 16 * jt, 128 * hd + 32 * ks, fr, fq);
                __builtin_amdgcn_sched_barrier(0);
#pragma unroll
                for (int ks = 0; ks < 4; ++ks) a = MF(kf[ks], qf[ks], a);
                float v[4];
#pragma unroll
                for (int r = 0; r < 4; ++r) { const int j = 16 * jt + 4 * fq + r; v[r] = (j <= trow) ? a[r] : 0.f; }
                sp.x = cvt_pk_bf16(v[0], v[1]); sp.y = cvt_pk_bf16(v[2], v[3]);
            }
            *(LAS u32x2*)(Sw + fr * 72 + 16 * jt + 4 * fq) = sp;
        }
        f32x4 o[4];
#pragma unroll
        for (int et = 0; et < 4; ++et) o[et] = (f32x4){0.f, 0.f, 0.f, 0.f};
#pragma unroll
        for (int ks = 0; ks < 4; ++ks)
#pragma unroll
            for (int et = 0; et < 4; ++et) o[et] = MF(hsf[ks][et], qf[ks], o[et]);
        if (hd == 0) {
            __builtin_amdgcn_sched_barrier(0);
            const bf16_t* HS1 = (const bf16_t*)(C.ws + WS_HS) + (size_t)(bn * 8 + 2 * hp + 1) * 16384;
#pragma unroll
            for (int ks = 0; ks < 4; ++ks)
#pragma unroll
                for (int et = 0; et < 4; ++et) hsf[ks][et] = frag_glb(HS1, 128, 64 * eh + 16 * et, 32 * ks, fr, fq);
            __builtin_amdgcn_sched_barrier(0);
        }
#pragma unroll
        for (int ks = 0; ks < 2; ++ks) {
            const bf16x8 sf = frag_nat(Sw, 72, 0, 32 * ks, fr, fq);
            bf16x8 vf[4];
#pragma unroll
            for (int et = 0; et < 4; ++et) vf[et] = frag_tr(Vi, 264, 32 * ks, 128 * hd + 64 * eh + 16 * et, fr, fq);
            __builtin_amdgcn_sched_barrier(0);
#pragma unroll
            for (int et = 0; et < 4; ++et) o[et] = MF(vf[et], sf, o[et]);
        }
        float ss = 0.f;
#pragma unroll
        for (int et = 0; et < 4; ++et) { ss += (o[et][0] * o[et][0] + o[et][1] * o[et][1]) + (o[et][2] * o[et][2] + o[et][3] * o[et][3]); oo[hd][et] = o[et]; }
        ss += __shfl_xor(ss, 16); ss += __shfl_xor(ss, 32);
        if (fq == 0) ssx[(hd * 2 + eh) * 64 + trow] = ss;
    }
    __syncthreads();
#pragma unroll
    for (int hd = 0; hd < 2; ++hd) {
        const float rstd = __builtin_amdgcn_rsqf((ssx[(hd * 2) * 64 + trow] + ssx[(hd * 2 + 1) * 64 + trow]) * (1.f / 128.f) + EPS);
        const float* gn = C.in[9] + hp * 256 + 128 * hd; bf16_t* prow = P + (size_t)(row0 + trow) * PP + COL_HQ + hp * 256 + 128 * hd;
#pragma unroll
        for (int et = 0; et < 4; ++et) {
            const int e = 64 * eh + 16 * et + 4 * fq; const f32x4 gg = ggv[hd][et]; const u32x2 sg = sgv[hd][et];
            const f32x4 y = oo[hd][et] * rstd * gg;
            u32x2 ov; ov.x = cvt_pk_bf16(y[0] * bflo(sg.x), y[1] * bfhi(sg.x)); ov.y = cvt_pk_bf16(y[2] * bflo(sg.y), y[3] * bfhi(sg.y));
            if (!(SK & 8) || ov.x == 0xDEADBEEFu) *(u32x2*)(prow + e) = ov;
        }
    }
    __syncthreads();
}

template <bool DUMMY> DI void scan_item(Ctx& C, int item) {
    u32x4* dq = (u32x4*)(C.ws + WS_END) + (threadIdx.x + blockIdx.x * NTHR) ;
    if (item < 65536) {
        const int bh = item >> 13, off = (item & 8191) * 8, b = bh >> 2, h = bh & 3;
        bf16_t* p = (bf16_t*)(C.ws + WS_RS) + ((size_t)(b * 64) * 4 + h) * 65536 + off;
        const float g = __expf(128.f * __logf(1.f - exp2f(-5.f - (float)h)));
        float s[8];
#pragma unroll
        for (int i = 0; i < 8; ++i) s[i] = 0.f;
        for (int n0 = 0; n0 < 64; n0 += 16) {
            u32x4 tv[16];
#pragma unroll
            for (int k = 0; k < 16; ++k) tv[k] = *(const u32x4*)(p + (size_t)(n0 + k) * 4 * 65536);
            __builtin_amdgcn_sched_barrier(0);
#pragma unroll
            for (int k = 0; k < 16; ++k) {
                u32x4* q = (u32x4*)(p + (size_t)(n0 + k) * 4 * 65536); const u32x4 t = tv[k];
                u32x4 o; o.x = cvt_pk_bf16(s[0], s[1]); o.y = cvt_pk_bf16(s[2], s[3]); o.z = cvt_pk_bf16(s[4], s[5]); o.w = cvt_pk_bf16(s[6], s[7]); if (DUMMY) *dq = o; else *q = o;
                s[0] = g * s[0] + bflo(t.x); s[1] = g * s[1] + bfhi(t.x); s[2] = g * s[2] + bflo(t.y); s[3] = g * s[3] + bfhi(t.y);
                s[4] = g * s[4] + bflo(t.z); s[5] = g * s[5] + bfhi(t.z); s[6] = g * s[6] + bflo(t.w); s[7] = g * s[7] + bfhi(t.w);
            }
            __builtin_amdgcn_sched_barrier(0);
        }
    } else {
        const int it = item - 65536, bh = it >> 11, off = (it & 2047) * 8, b = bh >> 3, h = bh & 7, d0 = off & 127;
        bf16_t* p = (bf16_t*)(C.ws + WS_HS) + ((size_t)(b * 128) * 8 + h) * 16384 + off;
        const float* dp = (const float*)(C.ws + WS_DEC) + ((size_t)(b * 128) * 8 + h) * 128 + d0;
        float s[8];
#pragma unroll
        for (int i = 0; i < 8; ++i) s[i] = 0.f;
        for (int n0 = 0; n0 < 128; n0 += 8) {
            u32x4 tv[8]; f32x4 g0[8], g1[8];
#pragma unroll
            for (int k = 0; k < 8; ++k) { tv[k] = *(const u32x4*)(p + (size_t)(n0 + k) * 8 * 16384);
                g0[k] = *(const f32x4*)(dp + (size_t)(n0 + k) * 8 * 128); g1[k] = *(const f32x4*)(dp + (size_t)(n0 + k) * 8 * 128 + 4); }
            __builtin_amdgcn_sched_barrier(0);
#pragma unroll
            for (int k = 0; k < 8; ++k) {
                u32x4* q = (u32x4*)(p + (size_t)(n0 + k) * 8 * 16384); const u32x4 t = tv[k];
                u32x4 o; o.x = cvt_pk_bf16(s[0], s[1]); o.y = cvt_pk_bf16(s[2], s[3]); o.z = cvt_pk_bf16(s[4], s[5]); o.w = cvt_pk_bf16(s[6], s[7]); if (DUMMY) *dq = o; else *q = o;
                s[0] = g0[k][0] * s[0] + bflo(t.x); s[1] = g0[k][1] * s[1] + bfhi(t.x); s[2] = g0[k][2] * s[2] + bflo(t.y); s[3] = g0[k][3] * s[3] + bfhi(t.y);
                s[4] = g1[k][0] * s[4] + bflo(t.z); s[5] = g1[k][1] * s[5] + bfhi(t.z); s[6] = g1[k][2] * s[6] + bflo(t.w); s[7] = g1[k][3] * s[7] + bfhi(t.w);
            }
            __builtin_amdgcn_sched_barrier(0);
        }
    }
}

template <int SKIP> DI void ret_pass_c(Ctx& C, LAS unsigned char* lds, int unit, bf16_t* Pdst, int rowmask) {
    bf16_t* P = (bf16_t*)(C.ws + WS_PROJ); const bf16_t* RS = (const bf16_t*)(C.ws + WS_RS) + (size_t)unit * 65536;
    int tid_l = threadIdx.x; asm volatile("" : "+v"(tid_l));
    const int lane_l = tid_l & 63;
    const int h = unit & 3, bn = unit >> 2, row0 = bn * 128, fr = lane_l & 15, fq = lane_l >> 4, w = C.wave, i0 = 16 * w;
    LAS short* Ki = (LAS short*)lds; LAS short* Vi = Ki + 128 * 264; LAS float* part = (LAS float*)(Vi + 128 * 264);
    const float lg = __logf(1.f - exp2f(-5.f - (float)h));
    const bf16_t* Qg = P + COL_RQ + h * 256;
    u32x2 sp[8];
    {
        bf16x8 qf[8];
        {
            u32x4 kst[8], vst[8];
#pragma unroll
            for (int it = 0; it < 8; ++it) { const int c = it * NTHR + tid_l, r = c >> 5, ch = c & 31; const bf16_t* src = P + (size_t)(row0 + r) * PP + h * 256 + ch * 8;
                vst[it] = *(const u32x4*)(src + COL_RV); kst[it] = *(const u32x4*)(src + COL_RK); }
#pragma unroll
            for (int ks = 0; ks < 8; ++ks) qf[ks] = frag_glb(Qg, PP, row0 + i0, 32 * ks, fr, fq);
#pragma unroll
            for (int it = 0; it < 8; ++it) { const int c = it * NTHR + tid_l, r = c >> 5, ch = c & 31;
                *(LAS u32x4*)(Vi + r * 264 + ch * 8) = vst[it]; *(LAS u32x4*)(Ki + r * 264 + ch * 8) = kst[it]; }
        }
        __syncthreads();
        const int irow = i0 + fr;
#pragma unroll
        for (int jt = 0; jt < 8; ++jt) {
            sp[jt] = (u32x2){0u, 0u};
            if (!(SKIP & 4) && jt <= w) {
                f32x4 a = (f32x4){0.f, 0.f, 0.f, 0.f};
                bf16x8 kf[8];
#pragma unroll
                for (int ks = 0; ks < 8; ++ks) kf[ks] = frag_nat(Ki, 264, 16 * jt, 32 * ks, fr, fq);
                __builtin_amdgcn_sched_barrier(0);
#pragma unroll
                for (int ks = 0; ks < 8; ++ks) a = MF(kf[ks], qf[ks], a);
                float v[4];
#pragma unroll
                for (int r = 0; r < 4; ++r) { const int j = 16 * jt + 4 * fq + r; v[r] = (j <= irow) ? a[r] * __expf(lg * (float)(irow - j)) : 0.f; }
                sp[jt].x = cvt_pk_bf16(v[0], v[1]); sp[jt].y = cvt_pk_bf16(v[2], v[3]);
            }
        }
    }
    __syncthreads();
    LAS short* Si = Ki;
#pragma unroll
    for (int jt = 0; jt < 8; ++jt) *(LAS u32x2*)(Si + (i0 + fr) * 136 + 16 * jt + 4 * fq) = sp[jt];
    const int ri = w >> 2, ei = w & 3;
    f32x4 o[4][4];
#pragma unroll
    for (int rt = 0; rt < 4; ++rt)
#pragma unroll
        for (int et = 0; et < 4; ++et) o[rt][et] = (f32x4){0.f, 0.f, 0.f, 0.f};
    {
        bf16x8 fa[2][2][4], fb[2][2][4];
#define RC_LOAD(buf, bt) do { _Pragma("unroll") for (int k2 = 0; k2 < 2; ++k2) { _Pragma("unroll") for (int rt = 0; rt < 4; ++rt) fa[buf][k2][rt] = frag_glb(Qg, PP, row0 + 64 * ri + 16 * rt, 32 * (2 * (bt) + k2), fr, fq); \
            _Pragma("unroll") for (int et = 0; et < 4; ++et) fb[buf][k2][et] = frag_glb(RS, 256, 64 * ei + 16 * et, 32 * (2 * (bt) + k2), fr, fq); } } while (0)
        if (!(SKIP & 1)) {
            RC_LOAD(0, 0);
#pragma unroll
            for (int bt = 0; bt < 4; ++bt) {
                if (bt < 3) { if (bt & 1) RC_LOAD(0, bt + 1); else RC_LOAD(1, bt + 1); }
                __builtin_amdgcn_sched_barrier(0);
#pragma unroll
                for (int k2 = 0; k2 < 2; ++k2)
#pragma unroll
                    for (int rt = 0; rt < 4; ++rt)
#pragma unroll
                        for (int et = 0; et < 4; ++et) o[rt][et] = MF(fb[bt & 1][k2][et], fa[bt & 1][k2][rt], o[rt][et]);
                __builtin_amdgcn_sched_barrier(0);
            }
        }
#undef RC_LOAD
    }
#pragma unroll
    for (int rt = 0; rt < 4; ++rt) { const float qd = __expf(lg * (float)(64 * ri + 16 * rt + fr + 1));
#pragma unroll
        for (int et = 0; et < 4; ++et) o[rt][et] = o[rt][et] * qd; }
    __syncthreads();
#pragma unroll
    for (int ks = 0; ks < 4; ++ks) {
        if (!(SKIP & 2) && 32 * ks <= 64 * ri + 63) {
            bf16x8 sf[4], vf[4];
#pragma unroll
            for (int rt = 0; rt < 4; ++rt) sf[rt] = frag_nat(Si, 136, 64 * ri + 16 * rt, 32 * ks, fr, fq);
#pragma unroll
            for (int et = 0; et < 4; ++et) vf[et] = frag_tr(Vi, 264, 32 * ks, 64 * ei + 16 * et, fr, fq);
            __builtin_amdgcn_sched_barrier(0);
#pragma unroll
            for (int rt = 0; rt < 4; ++rt)
#pragma unroll
                for (int et = 0; et < 4; ++et) o[rt][et] = MF(vf[et], sf[rt], o[rt][et]);
        }
    }
#pragma unroll
    for (int rt = 0; rt < 4; ++rt) {
        float s = 0.f, q = 0.f;
#pragma unroll
        for (int et = 0; et < 4; ++et) { const f32x4 x = o[rt][et]; s += (x[0] + x[1]) + (x[2] + x[3]); q += (x[0] * x[0] + x[1] * x[1]) + (x[2] * x[2] + x[3] * x[3]); }
        s += __shfl_xor(s, 16); s += __shfl_xor(s, 32); q += __shfl_xor(q, 16); q += __shfl_xor(q, 32);
        if (fq == 0) { const int r = 64 * ri + 16 * rt + fr; part[(ei * 128 + r) * 2] = s; part[(ei * 128 + r) * 2 + 1] = q; }
    }
    u32x2 sgv[4][4];
#pragma unroll
    for (int rt = 0; rt < 4; ++rt)
#pragma unroll
        for (int et = 0; et < 4; ++et) sgv[rt][et] = *(const u32x2*)(P + (size_t)(row0 + 64 * ri + 16 * rt + fr) * PP + h * 256 + COL_RG + 64 * ei + 16 * et + 4 * fq);
    const float* gn = C.in[7] + h * 256;
    f32x4 ggv[4];
#pragma unroll
    for (int et = 0; et < 4; ++et) ggv[et] = *(const f32x4*)(gn + 64 * ei + 16 * et + 4 * fq);
    __builtin_amdgcn_sched_barrier(0);
    __syncthreads();
#pragma unroll
    for (int rt = 0; rt < 4; ++rt) {
        const int r = 64 * ri + 16 * rt + fr;
        float s = 0.f, q = 0.f;
#pragma unroll
        for (int e4 = 0; e4 < 4; ++e4) { s += part[(e4 * 128 + r) * 2]; q += part[(e4 * 128 + r) * 2 + 1]; }
        const float mu = s * (1.f / 256.f); const float rstd = __builtin_amdgcn_rsqf(fmaxf(q * (1.f / 256.f) - mu * mu, 0.f) + EPS);
        const bf16_t* prow = P + (size_t)(row0 + r) * PP + h * 256;
        bf16_t* drow = Pdst + (size_t)((row0 + r) & rowmask) * PP + h * 256 + COL_RQ;
#pragma unroll
        for (int et = 0; et < 4; ++et) {
            const int e = 64 * ei + 16 * et + 4 * fq; const f32x4 gg = ggv[et]; const u32x2 sg = sgv[rt][et];
            const f32x4 y = (o[rt][et] - mu) * rstd * gg;
            u32x2 ov; ov.x = cvt_pk_bf16(y[0] * bflo(sg.x), y[1] * bfhi(sg.x)); ov.y = cvt_pk_bf16(y[2] * bflo(sg.y), y[3] * bfhi(sg.y));
            if (rowmask != 511 || ov.x == 0xDEADBEEFu) *(u32x2*)(drow + e) = ov;
        }
    }
    __syncthreads();
}

DI void hgrn_pass_c(Ctx& C, LAS unsigned char* lds, int unit, bf16_t* Pdst, int rowmask) {
    bf16_t* P = (bf16_t*)(C.ws + WS_PROJ); const bf16_t* HS = (const bf16_t*)(C.ws + WS_HS) + (size_t)unit * 16384;
    const int h = unit & 7, bn = unit >> 3, row0 = bn * 64, fr = C.lane & 15, fq = C.lane >> 4, w = C.wave;
    LAS short* Qt = (LAS short*)lds; LAS short* Kt = Qt + 64 * 136; LAS short* Qc = Kt + 64 * 136; LAS short* Vi = Qc + 64 * 136;
    LAS float* segtot = (LAS float*)(Vi + 64 * 136); LAS float* ssx = segtot + 512; LAS short* Sw = (LAS short*)(ssx + 128) + w * 16 * 72;
    const int d = C.tid & 127, seg = C.tid >> 7;
#pragma unroll
    for (int it = 0; it < 2; ++it) { const int c = it * NTHR + C.tid, r = c >> 4, ch = c & 15;
        *(LAS u32x4*)(Vi + r * 136 + ch * 8) = *(const u32x4*)(P + (size_t)(row0 + r) * PP + COL_HI + h * 128 + ch * 8); }
    float qv[16];
#pragma unroll
    for (int r = 0; r < 16; ++r) qv[r] = bf2f(P[(size_t)(row0 + 16 * seg + r) * PP + COL_HQ + h * 128 + d]);
    const int rb = w & 3, eh = w >> 2, t0 = 16 * rb, trow = t0 + fr;
    bf16x8 hsf[4][4];
#pragma unroll
    for (int ks = 0; ks < 4; ++ks)
#pragma unroll
        for (int et = 0; et < 4; ++et) hsf[ks][et] = frag_glb(HS, 128, 64 * eh + 16 * et, 32 * ks, fr, fq);
    u32x2 sgv[4];
#pragma unroll
    for (int et = 0; et < 4; ++et) sgv[et] = *(const u32x2*)(P + (size_t)(row0 + trow) * PP + h * 128 + COL_HG + 64 * eh + 16 * et + 4 * fq);
    HPrep hp; hgrn_prep(C, segtot, P, row0, h, hp);
#pragma unroll
    for (int r = 0; r < 16; ++r) {
        const float c = hp.cum[r] + hp.off; const int a = (16 * seg + r) * 136 + d;
        Qt[a] = (short)(cvt_pk_bf16(qv[r] * __expf(c - hp.cmid), 0.f) & 0xffffu);
        Kt[a] = (short)(cvt_pk_bf16(hp.kk[r] * __expf(hp.cmid - c), 0.f) & 0xffffu);
        Qc[a] = (short)(cvt_pk_bf16(qv[r] * __expf(c), 0.f) & 0xffffu);
    }
    __syncthreads();
    bf16x8 qf[4];
#pragma unroll
    for (int ks = 0; ks < 4; ++ks) qf[ks] = frag_nat(Qt, 136, t0, 32 * ks, fr, fq);
#pragma unroll
    for (int jt = 0; jt < 4; ++jt) {
        u32x2 sp = (u32x2){0u, 0u};
        if (jt <= rb) {
            f32x4 a = (f32x4){0.f, 0.f, 0.f, 0.f};
#pragma unroll
            for (int ks = 0; ks < 4; ++ks) a = MF(frag_nat(Kt, 136, 16 * jt, 32 * ks, fr, fq), qf[ks], a);
            float v[4];
#pragma unroll
            for (int r = 0; r < 4; ++r) { const int j = 16 * jt + 4 * fq + r; v[r] = (j <= trow) ? a[r] : 0.f; }
            sp.x = cvt_pk_bf16(v[0], v[1]); sp.y = cvt_pk_bf16(v[2], v[3]);
        }
        *(LAS u32x2*)(Sw + fr * 72 + 16 * jt + 4 * fq) = sp;
    }
    f32x4 o[4];
#pragma unroll
    for (int et = 0; et < 4; ++et) o[et] = (f32x4){0.f, 0.f, 0.f, 0.f};
#pragma unroll
    for (int ks = 0; ks < 4; ++ks) {
        const bf16x8 qcf = frag_nat(Qc, 136, t0, 32 * ks, fr, fq);
#pragma unroll
        for (int et = 0; et < 4; ++et) o[et] = MF(hsf[ks][et], qcf, o[et]);
    }
    __syncthreads();
#pragma unroll
    for (int ks = 0; ks < 2; ++ks) {
        const bf16x8 sf = frag_nat(Sw, 72, 0, 32 * ks, fr, fq);
#pragma unroll
        for (int et = 0; et < 4; ++et) o[et] = MF(frag_tr(Vi, 136, 32 * ks, 64 * eh + 16 * et, fr, fq), sf, o[et]);
    }
    float ss = 0.f;
#pragma unroll
    for (int et = 0; et < 4; ++et) ss += (o[et][0] * o[et][0] + o[et][1] * o[et][1]) + (o[et][2] * o[et][2] + o[et][3] * o[et][3]);
    ss += __shfl_xor(ss, 16); ss += __shfl_xor(ss, 32);
    if (fq == 0) ssx[eh * 64 + trow] = ss;
    __syncthreads();
    const float rstd = __builtin_amdgcn_rsqf((ssx[trow] + ssx[64 + trow]) * (1.f / 128.f) + EPS);
    const float* gn = C.in[9] + h * 128; bf16_t* prow = P + (size_t)(row0 + trow) * PP + h * 128;
#pragma unroll
    for (int et = 0; et < 4; ++et) {
        const int e = 64 * eh + 16 * et + 4 * fq; const f32x4 gg = *(const f32x4*)(gn + e); const u32x2 sg = sgv[et];
        const f32x4 y = o[et] * rstd * gg;
        u32x2 ov; ov.x = cvt_pk_bf16(y[0] * bflo(sg.x), y[1] * bfhi(sg.x)); ov.y = cvt_pk_bf16(y[2] * bflo(sg.y), y[3] * bfhi(sg.y));
        if (rowmask != 511 || ov.x == 0xDEADBEEFu) *(u32x2*)(Pdst + (size_t)((row0 + trow) & rowmask) * PP + h * 128 + COL_HQ + e) = ov;
    }
    __syncthreads();
}

struct Args { const float* in[16]; float* out; unsigned char* ws; int ph_lo, ph_hi; };
constexpr int N_PHASES = 11;

__global__ void __launch_bounds__(NTHR, 2) mega_fwd(Args args) {
    extern __shared__ __attribute__((aligned(16))) unsigned char lds_raw[];
    LAS unsigned char* lds = (LAS unsigned char*)lds_raw;
    Ctx C;
#pragma unroll
    for (int i = 0; i < 16; ++i) C.in[i] = args.in[i];
    C.out = args.out; C.ws = args.ws; C.tid = threadIdx.x; C.lane = C.tid & 63; C.wave = __builtin_amdgcn_readfirstlane(C.tid >> 6); C.G = gridDim.x; C.bx = blockIdx.x;
    const int lo = args.ph_lo, hi = args.ph_hi;
    unsigned char* ws = args.ws;
    bf16_t* WGU = (bf16_t*)(ws + WS_WGU); bf16_t* WDt = (bf16_t*)(ws + WS_WD); bf16_t* WIN = (bf16_t*)(ws + WS_WIN); bf16_t* WOUT = (bf16_t*)(ws + WS_WOUT);
    bf16_t* XN = (bf16_t*)(ws + WS_XN); bf16_t* HB = (bf16_t*)(ws + WS_H); bf16_t* PROJ = (bf16_t*)(ws + WS_PROJ);
    float* SS1 = (float*)(ws + WS_SS1); float* SS2 = (float*)(ws + WS_SS2); float* SS3 = (float*)(ws + WS_SS3);
#define IN(k) (lo <= (k) && (k) < hi)
    unsigned* barw = (unsigned*)(ws + WS_BAR);
    volatile LAS unsigned* misc = (volatile LAS unsigned*)(lds + LDS_MISC);
    if (C.tid < 2) misc[C.tid] = 0u;
    if (C.bx == 0 && hi - lo > 1) for (int i = C.tid; i < XCD_BAR_WORDS; i += NTHR) barw[i] = 0u;
    __syncthreads();
    XcdBarrier xbar; xbar.bar = barw; xbar.x = 0; xbar.st = misc;
#define SEAM(k) do { if (IN(k) && IN((k) + 1)) { if ((k) == 0) { cg::this_grid().sync(); xbar = xcd_barrier_post(barw, misc); } else xcd_barrier(xbar); } } while (0)

    if (IN(0)) { phase_prologue(C, lds);
#if MK_DUP == 0
        phase_prologue(C, lds);
#endif
    }
    SEAM(0);
#if MK_DUP == 20
    for (int r = 0; r < 10; ++r) cg::this_grid().sync();
#endif
    if (IN(1)) {
#if MK_DUP == 1
        { pg8::Gemm g{XN, WGU, M, 2 * FF, D, 0}; pg8::StaticOrder S; S.init(M, 2 * FF, C.G, C.bx); pg8::EpiGateUp E{HB, nullptr, true}; pg8::gemm_phase(lds, g, S, E); }
#endif
        pg8::Gemm g{XN, WGU, M, 2 * FF, D, 0}; pg8::StaticOrder S; S.init(M, 2 * FF, C.G, C.bx);
        pg8::EpiGateUp E{HB, nullptr, false}; pg8::gemm_phase(lds, g, S, E);
    }
    SEAM(1);
    if (IN(2)) {
        pg8::Gemm g{HB, WDt, M, D, FF, 0}; pg8::StaticOrder S; S.init(M, D, C.G, C.bx);
        pg8::EpiResid E{C.in[0], C.out, 0.5f, C.in[5], XN, SS1}; pg8::gemm_phase(lds, g, S, E);
    }
    SEAM(2);
    if (IN(3)) {
        pg8::Gemm g{XN, WIN, M, NIN, D, 0}; pg8::StaticOrder S; S.init(M, NIN, C.G, C.bx);
        pg8::EpiProj E{PROJ, SS1}; pg8::gemm_phase(lds, g, S, E);
    }
    SEAM(3);
    if (IN(4)) {
#if MK_DUP == 4
        for (int u = C.bx; u < 512 + 2048; u += C.G) { if (u < 512) ret_pass_a(C, lds, u); else hgrn_pass_a(C, lds, u - 512); }
#endif
        for (int u = C.bx; u < 512 + 1024; u += C.G) { if (u < 512) ret_pass_a(C, lds, u); else hgrn_pass_a2(C, lds, u - 512); }
    }
    SEAM(4);
    if (IN(5)) {
#if MK_DUP == 5
        for (int it = C.bx * NTHR + C.tid; it < 65536 + 32768; it += C.G * NTHR) scan_item<true>(C, it);
#endif
        for (int it = C.bx * NTHR + C.tid; it < 65536 + 32768; it += C.G * NTHR) scan_item<false>(C, it);
        LAS float* scr = (LAS float*)(lds + C.wave * 16384);
        for (int it = C.bx * NWAVES + C.wave; it < 3 * 5632; it += C.G * NWAVES) convert_ffn_item(it, C.in[12], C.in[13], C.in[14], WGU, WDt, scr, C.lane);
    }
    SEAM(5);
    if (IN(6)) {
#if MK_DUP == 6
        for (int u = C.bx; u < 512 + 2048; u += C.G) { if (u < 512) ret_pass_c<MK_SKIP>(C, lds, u, (bf16_t*)(ws + WS_END), 511); else hgrn_pass_c(C, lds, u - 512, (bf16_t*)(ws + WS_END), 511); }
#endif
#if MK_DUP == 61
        for (int u = C.bx; u < 512; u += C.G) ret_pass_c<MK_SKIP>(C, lds, u, (bf16_t*)(ws + WS_END), 511);
#endif
#if MK_DUP == 63
        for (int u = C.bx + 512; u < 512 + 1024; u += C.G) hgrn_pass_c2<8 | MK_SKIP>(C, lds, u - 512);
#endif
#if MK_DUP == 62
        for (int u = C.bx + 512; u < 512 + 2048; u += C.G) hgrn_pass_c(C, lds, u - 512, (bf16_t*)(ws + WS_END), 511);
#endif
#if MK_DUP == 41
        for (int u = C.bx; u < 512; u += C.G) ret_pass_a(C, lds, u);
#endif
        for (int u = C.bx; u < 512 + 1024; u += C.G) { if (u < 512) ret_pass_c<0>(C, lds, u, PROJ, 0x7fffffff); else hgrn_pass_c2<0>(C, lds, u - 512); }
    }
    SEAM(6);
    if (IN(7)) {
        pg8::Gemm g{PROJ, WOUT, M, D, D, PP}; pg8::StaticOrder S; S.init(M, D, C.G, C.bx);
        pg8::EpiResid E{C.out, C.out, 1.0f, C.in[11], XN, SS2}; pg8::gemm_phase(lds, g, S, E);
    }
    SEAM(7);
    if (IN(8)) {
        pg8::Gemm g{XN, WGU, M, 2 * FF, D, 0}; pg8::StaticOrder S; S.init(M, 2 * FF, C.G, C.bx);
        pg8::EpiGateUp E{HB, SS2, false}; pg8::gemm_phase(lds, g, S, E);
    }
    SEAM(8);
    if (IN(9)) {
        pg8::Gemm g{HB, WDt, M, D, FF, 0}; pg8::StaticOrder S; S.init(M, D, C.G, C.bx);
        pg8::EpiResid E{C.out, C.out, 0.5f, nullptr, nullptr, nullptr}; pg8::gemm_phase(lds, g, S, E);
    }
    SEAM(9);
    if (IN(10)) {
        const float* gf = C.in[15];
        f32x4 gfv[8];
#pragma unroll
        for (int j = 0; j < 8; ++j) gfv[j] = *((const f32x4*)gf + 64 * j + C.lane);
        {
            const int gw = C.bx * NWAVES + C.wave, NGW = C.G * NWAVES;
            f32x4 v[8], nv[8];
            if (gw < M) {
#pragma unroll
                for (int j = 0; j < 8; ++j) v[j] = *((const f32x4*)(C.out + (size_t)gw * D) + C.lane + 64 * j);
            }
            for (int m = gw; m < M; m += NGW) {
                const int mn = (m + NGW < M) ? m + NGW : m;
#pragma unroll
                for (int j = 0; j < 8; ++j) nv[j] = *((const f32x4*)(C.out + (size_t)mn * D) + C.lane + 64 * j);
                __builtin_amdgcn_sched_barrier(0);
                float s = 0.f;
#pragma unroll
                for (int j = 0; j < 8; ++j) s += (v[j][0] * v[j][0] + v[j][1] * v[j][1]) + (v[j][2] * v[j][2] + v[j][3] * v[j][3]);
                const float rs = 1.f / sqrtf(wave_sum(s) * (1.f / D) + EPS);
                f32x4* xr = (f32x4*)(C.out + (size_t)m * D) + C.lane;
#pragma unroll
                for (int j = 0; j < 8; ++j) xr[64 * j] = v[j] * rs * gfv[j];
                __builtin_amdgcn_sched_barrier(0);
#pragma unroll
                for (int j = 0; j < 8; ++j) v[j] = nv[j];
            }
        }
    }
#undef IN
#undef SEAM
}

extern "C" void kernel_launch(void* const* d_in, const int* in_sizes, int n_in, void* d_out, int out_size, void* d_ws, size_t ws_size, hipStream_t stream) {
    static int grid = 0;
    if (grid == 0) {
        if (n_in != 16 || out_size != M * D || ws_size < WS_END) { fprintf(stderr, "kernel_launch: unexpected shapes (n_in %d, out %d, ws %zu)\n", n_in, out_size, ws_size); grid = -1; return; }
        int dev = 0, cus = 0, per_cu = 0;
        hipGetDevice(&dev); hipDeviceGetAttribute(&cus, hipDeviceAttributeMultiprocessorCount, dev);
        if (hipFuncSetAttribute((const void*)mega_fwd, hipFuncAttributeMaxDynamicSharedMemorySize, LDS_BYTES) != hipSuccess) { fprintf(stderr, "kernel_launch: hipFuncSetAttribute failed\n"); grid = -1; return; }
        hipOccupancyMaxActiveBlocksPerMultiprocessor(&per_cu, (const void*)mega_fwd, NTHR, LDS_BYTES);
        if (per_cu < 1) { fprintf(stderr, "kernel_launch: occupancy query says %d blocks per CU\n", per_cu); per_cu = 1; }
        (void)hipGetLastError();
        grid = cus * 1;
        fprintf(stderr, "kernel_launch: grid %d (cus %d, per_cu %d)\n", grid, cus, per_cu);
    }
    if (grid < 0) return;
    Args a{};
    for (int i = 0; i < 16; ++i) a.in[i] = (const float*)d_in[i];
    a.out = (float*)d_out; a.ws = (unsigned char*)d_ws;
#if MK_PER_PHASE
#ifndef MK_LASTP
#define MK_LASTP 10
#endif
    for (int p = 0; p < N_PHASES; ++p) { if (p > MK_LASTP && p != 10) continue; a.ph_lo = p; a.ph_hi = p + 1; hipLaunchKernelGGL(mega_fwd, dim3(grid), dim3(NTHR), LDS_BYTES, stream, a); }
#else
    a.ph_lo = 0; a.ph_hi = N_PHASES;
    void* kargs[] = {&a};
    hipError_t e = hipLaunchCooperativeKernel((const void*)mega_fwd, dim3(grid), dim3(NTHR), kargs, LDS_BYTES, stream);
    if (e != hipSuccess) fprintf(stderr, "kernel_launch: cooperative launch failed: %s (grid %d)\n", hipGetErrorString(e), grid);
#endif
}
```

```cpp
#include <hip/hip_runtime.h>
#include <hip/hip_cooperative_groups.h>
#include <cstdio>
#include <cstdint>
namespace cg = cooperative_groups;

#define MK_LASTP 10
#define MK_SKIP 0
#define PG8_ALIGN 1
#ifndef MK_DUP
#define MK_DUP -1
#endif
#ifndef MK_PER_PHASE
#define MK_PER_PHASE 0
#endif

#define LAS __attribute__((address_space(3)))
#define DI __device__ __forceinline__
typedef unsigned short bf16_t;
typedef short bf16x8 __attribute__((ext_vector_type(8)));
typedef short s16x4 __attribute__((ext_vector_type(4)));
typedef float f32x4 __attribute__((ext_vector_type(4)));
typedef unsigned u32x4 __attribute__((ext_vector_type(4)));
typedef unsigned u32x2 __attribute__((ext_vector_type(2)));

constexpr int SEQ = 8192, M = 16384, D = 2048, FF = 5632, NIN = 8192;
constexpr int PP = NIN + 64;
constexpr float EPS = 1e-6f;
constexpr int COL_RQ = 0, COL_HQ = 1024, COL_RK = 2048, COL_RV = 3072, COL_RG = 4096, COL_HF = 5120, COL_HI = 6144, COL_HG = 7168;
constexpr size_t MiB = 1u << 20;
constexpr size_t WS_SS1 = 0, WS_SS2 = 64 * 1024, WS_SS3 = 128 * 1024;
constexpr size_t WS_BAR = 256 * 1024;
constexpr size_t WS_DEC = 1 * MiB;
constexpr size_t WS_WGU = 2 * MiB, WS_WD = 46 * MiB, WS_WIN = 68 * MiB, WS_WOUT = 100 * MiB;
constexpr size_t WS_XN = 108 * MiB;
constexpr size_t WS_RS = 108 * MiB;
constexpr size_t WS_PROJ = 172 * MiB;
constexpr size_t WS_H = 172 * MiB;
constexpr size_t WS_HS = 432 * MiB;
constexpr size_t WS_END = 496 * MiB;
constexpr int LDS_BYTES = 147456, LDS_MISC = 143360;
constexpr int NWAVES = 8, NTHR = 512;

typedef float f32x2_t __attribute__((ext_vector_type(2)));
typedef __bf16 bf16x2_t __attribute__((ext_vector_type(2)));
DI unsigned cvt_pk_bf16(float lo, float hi) { const f32x2_t v = {lo, hi}; return __builtin_bit_cast(unsigned, __builtin_convertvector(v, bf16x2_t)); }
DI float bf2f(unsigned short v) { return __uint_as_float(((unsigned)v) << 16); }
DI float bflo(unsigned w) { return __uint_as_float(w << 16); }
DI float bfhi(unsigned w) { return __uint_as_float(w & 0xffff0000u); }
DI float siluf(float x) { return x * __builtin_amdgcn_rcpf(1.f + __expf(-x)); }
DI float wave_sum(float v) {
#pragma unroll
    for (int o = 1; o < 64; o <<= 1) v += __shfl_xor(v, o);
    return v;
}

namespace pg8 {
constexpr int BM = 256, BK = 64, HALF = 128, HTB = HALF * BK * 2, STAGE_BYTES = 8 * HTB, NXCD = 8, WGM = 4;
__host__ __device__ __forceinline__ int lds_byte(int r, int c) { const int st = (r >> 4) * 2 + (c >> 5), rr = r & 15, cc = c & 31, ob = rr * 64 + cc * 2; return st * 1024 + (ob ^ (((ob >> 9) & 1) << 5)); }
__host__ __device__ __forceinline__ void stage_rc(int b, int& R, int& C) { const int st = b / 1024, sb = b % 1024, swz = sb ^ (((sb >> 9) & 1) << 5); R = (st >> 1) * 16 + swz / 64; C = (st & 1) * 32 + (swz % 64) / 2; }
__host__ __device__ __forceinline__ int perm32(int rho) { const int n = rho >> 4, i = rho & 15; return 8 * (i >> 2) + 4 * n + (i & 3); }
struct Unit { int pm, pn; };
struct Gemm { const bf16_t* A; const bf16_t* Bt; int M, N, K, lda; };
struct StaticOrder {
    int nM, nN, nwg, G, c;
    __device__ void init(int M_, int N_, int G_, int c_) { nM = M_ / BM; nN = N_ / BM; nwg = nM * nN; G = G_; c = c_; }
    __device__ bool next(int i, Unit& u) const {
        const long L = (long)i * G + c; if (L >= nwg) return false;
        int wgid = (int)L; { const int q = nwg / NXCD, r = nwg % NXCD, xcd = wgid % NXCD, off = wgid / NXCD; wgid = (xcd < r ? xcd * (q + 1) : r * (q + 1) + (xcd - r) * q) + off; }
        const int nig = WGM * nN, gid = wgid / nig, fm = gid * WGM, gsz = (nM - fm) < WGM ? (nM - fm) : WGM;
        u.pm = fm + ((wgid % nig) % gsz); u.pn = (wgid % nig) / gsz; return true;
    }
};

struct EpiGateUp {
    static constexpr bool PERM = true;
    bf16_t* H; const float* rowss; bool cheap;
    DI void operator()(const f32x4 (&acc)[2][2][4][2], const Unit& u, int wr, int wc, int fr, int fq) const {
        const int row0 = u.pm * BM + wr * 64 + fr, col0 = u.pn * HALF + wc * 32 + 8 * fq;
        float rsv[2][4];
#pragma unroll
        for (int ai = 0; ai < 2; ++ai)
#pragma unroll
            for (int m = 0; m < 4; ++m) rsv[ai][m] = rowss ? rowss[row0 + ai * HALF + m * 16] : 0.f;
        __builtin_amdgcn_sched_barrier(0);
#pragma unroll
        for (int ai = 0; ai < 2; ++ai)
#pragma unroll
            for (int m = 0; m < 4; ++m) {
                const int row = row0 + ai * HALF + m * 16;
                float rs = 1.f; if (rowss) rs = __builtin_amdgcn_rsqf(rsv[ai][m] * (1.f / D) + EPS);
                float h[8];
#pragma unroll
                for (int n = 0; n < 2; ++n)
#pragma unroll
                    for (int i = 0; i < 4; ++i) { const float g = acc[ai][0][m][n][i] * rs, up = acc[ai][1][m][n][i] * rs; h[4 * n + i] = cheap ? g + up : siluf(g) * up; }
                u32x4 w; w.x = cvt_pk_bf16(h[0], h[1]); w.y = cvt_pk_bf16(h[2], h[3]); w.z = cvt_pk_bf16(h[4], h[5]); w.w = cvt_pk_bf16(h[6], h[7]);
                *(u32x4*)(H + (size_t)row * FF + col0) = w;
            }
    }
};
struct EpiResid {
    static constexpr bool PERM = false;
    const float* base; float* out; float alpha; const float* gnext; bf16_t* XN; float* rowss; bf16_t* OB;
    DI void operator()(const f32x4 (&acc)[2][2][4][2], const Unit& u, int wr, int wc, int fr, int fq) const {
        const int row0 = u.pm * BM + wr * 64 + fr, col0 = u.pn * BM + wc * 32 + 4 * fq;
        f32x4 gv[2][2];
#pragma unroll
        for (int bj = 0; bj < 2; ++bj)
#pragma unroll
            for (int n = 0; n < 2; ++n) gv[bj][n] = gnext ? *(const f32x4*)(gnext + col0 + bj * HALF + n * 16) : (f32x4){1.f, 1.f, 1.f, 1.f};
#pragma unroll
        for (int ai = 0; ai < 2; ++ai) {
            f32x4 bv[4][2][2];
#pragma unroll
            for (int m = 0; m < 4; ++m)
#pragma unroll
                for (int bj = 0; bj < 2; ++bj)
#pragma unroll
                    for (int n = 0; n < 2; ++n) bv[m][bj][n] = *(const f32x4*)(base + (size_t)(row0 + ai * HALF + m * 16) * D + col0 + bj * HALF + n * 16);
            __builtin_amdgcn_sched_barrier(0);
#pragma unroll
            for (int m = 0; m < 4; ++m) {
                const int row = row0 + ai * HALF + m * 16; const size_t off = (size_t)row * D + col0; float ss = 0.f;
#pragma unroll
                for (int bj = 0; bj < 2; ++bj)
#pragma unroll
                    for (int n = 0; n < 2; ++n) {
                        const f32x4 v = bv[m][bj][n] + acc[ai][bj][m][n] * alpha;
                        if (OB) { u32x2 w; w.x = cvt_pk_bf16(v[0], v[1]); w.y = cvt_pk_bf16(v[2], v[3]); *(u32x2*)(OB + off + bj * HALF + n * 16) = w; }
                        else *(f32x4*)(out + off + bj * HALF + n * 16) = v;
                        ss += (v[0] * v[0] + v[1] * v[1]) + (v[2] * v[2] + v[3] * v[3]);
                        if (XN) { const f32x4 t = v * gv[bj][n]; u32x2 w; w.x = cvt_pk_bf16(t[0], t[1]); w.y = cvt_pk_bf16(t[2], t[3]); *(u32x2*)(XN + off + bj * HALF + n * 16) = w; }
                    }
                ss += __shfl_xor(ss, 16); ss += __shfl_xor(ss, 32);
                if (rowss && fq == 0) atomicAdd(rowss + row, ss);
            }
            __builtin_amdgcn_sched_barrier(0);
        }
    }
};
struct EpiProj {
    static constexpr bool PERM = true;
    bf16_t* P; const float* rowss;
    DI void operator()(const f32x4 (&acc)[2][2][4][2], const Unit& u, int wr, int wc, int fr, int fq) const {
        const int row0 = u.pm * BM + wr * 64 + fr, col0 = u.pn * BM + wc * 32 + 8 * fq, type = u.pn >> 2;
        float rsv[2][4];
#pragma unroll
        for (int ai = 0; ai < 2; ++ai)
#pragma unroll
            for (int m = 0; m < 4; ++m) rsv[ai][m] = rowss[row0 + ai * HALF + m * 16];
        __builtin_amdgcn_sched_barrier(0);
        if (type == 0 || type == 2) {
            const float qs = (type == 0) ? 0.0625f : 1.f;
            float invf[8];
#pragma unroll
            for (int j = 0; j < 8; ++j) invf[j] = exp2f(-(float)(wc * 32 + 8 * fq + j) * (13.287712379549449f / 128.f));
#pragma unroll
            for (int ai = 0; ai < 2; ++ai)
#pragma unroll
                for (int m = 0; m < 4; ++m) {
                    const int row = row0 + ai * HALF + m * 16; const float rs = __builtin_amdgcn_rsqf(rsv[ai][m] * (1.f / D) + EPS) * qs;
                    const float pos = (float)(row & (SEQ - 1));
                    float o1[8], o2[8];
#pragma unroll
                    for (int n = 0; n < 2; ++n)
#pragma unroll
                        for (int i = 0; i < 4; ++i) {
                            const float ang = pos * invf[4 * n + i]; const float rev = __builtin_amdgcn_fractf(ang * 0.15915494309189535f);
                            const float sn = __builtin_amdgcn_sinf(rev), cs = __builtin_amdgcn_cosf(rev);
                            const float x1 = acc[ai][0][m][n][i] * rs, x2 = acc[ai][1][m][n][i] * rs;
                            o1[4 * n + i] = x1 * cs - x2 * sn; o2[4 * n + i] = x2 * cs + x1 * sn;
                        }
                    u32x4 w; w.x = cvt_pk_bf16(o1[0], o1[1]); w.y = cvt_pk_bf16(o1[2], o1[3]); w.z = cvt_pk_bf16(o1[4], o1[5]); w.w = cvt_pk_bf16(o1[6], o1[7]);
                    *(u32x4*)(P + (size_t)row * PP + col0) = w;
                    w.x = cvt_pk_bf16(o2[0], o2[1]); w.y = cvt_pk_bf16(o2[2], o2[3]); w.z = cvt_pk_bf16(o2[4], o2[5]); w.w = cvt_pk_bf16(o2[6], o2[7]);
                    *(u32x4*)(P + (size_t)row * PP + col0 + HALF) = w;
                }
        } else {
            const bool act = (type == 1 || type == 4 || type == 7);
#pragma unroll
            for (int ai = 0; ai < 2; ++ai)
#pragma unroll
                for (int m = 0; m < 4; ++m) {
                    const int row = row0 + ai * HALF + m * 16; const float rs = __builtin_amdgcn_rsqf(rsv[ai][m] * (1.f / D) + EPS);
#pragma unroll
                    for (int bj = 0; bj < 2; ++bj) {
                        float v[8];
#pragma unroll
                        for (int n = 0; n < 2; ++n)
#pragma unroll
                            for (int i = 0; i < 4; ++i) { const float x = acc[ai][bj][m][n][i] * rs; v[4 * n + i] = act ? siluf(x) : x; }
                        u32x4 w; w.x = cvt_pk_bf16(v[0], v[1]); w.y = cvt_pk_bf16(v[2], v[3]); w.z = cvt_pk_bf16(v[4], v[5]); w.w = cvt_pk_bf16(v[6], v[7]);
                        *(u32x4*)(P + (size_t)row * PP + col0 + bj * HALF) = w;
                    }
                }
        }
    }
};

template <class Epi>
DI void gemm_phase(LAS unsigned char* lds, const Gemm g, const StaticOrder& S, const Epi& E) {
    const int tid = threadIdx.x, wid = __builtin_amdgcn_readfirstlane(tid >> 6), lane = tid & 63, wr = wid >> 2, wc = wid & 3, fr = lane & 15, fq = lane >> 4;
    const int K = g.K, nt = K / BK, lda = g.lda;
    unsigned voffA[2], voffB[2];
#pragma unroll
    for (int i = 0; i < 2; ++i) { int R, C; stage_rc(tid * 16 + i * 8192, R, C); const int Rb = Epi::PERM ? ((R & ~31) + perm32(R & 31)) : R;
        voffA[i] = (unsigned)(R * lda + C) * 2u; voffB[i] = (unsigned)(Rb * K + C) * 2u; }
    const size_t kstep = (size_t)(BK * 2);
    const size_t hstepA = (size_t)HALF * lda * 2, hstepB = (size_t)HALF * K * 2;
    const size_t tstepA = 2 * hstepA, tstepB = 2 * hstepB;
    const unsigned ldsw = (unsigned)wid * 1024u;
    const int aoff = lds_byte(wr * 64 + fr, fq * 8), boff = lds_byte(wc * 32 + fr, fq * 8);
#define PG8_SA(b, h) (((b) * 2 + (h)) * HTB)
#define PG8_SB(b, h) ((4 + (b) * 2 + (h)) * HTB)
#define PG8_STAGE(bufoff, gbase, voff) do { _Pragma("unroll") for (int _i = 0; _i < 2; ++_i) \
        __builtin_amdgcn_global_load_lds((const unsigned*)((const char*)(gbase) + (voff)[_i]), (LAS unsigned*)(lds + (bufoff) + ldsw + _i * 8192), 16, 0, 0); } while (0)
#define PG8_LDA(dst, b, h) do { _Pragma("unroll") for (int m = 0; m < 4; ++m) _Pragma("unroll") for (int k = 0; k < 2; ++k) dst[m][k] = *(const LAS bf16x8*)(lds + PG8_SA(b, h) + aoff + m * 2048 + k * 1024); } while (0)
#define PG8_LDB(dst, b, h) do { _Pragma("unroll") for (int n = 0; n < 2; ++n) _Pragma("unroll") for (int k = 0; k < 2; ++k) dst[n][k] = *(const LAS bf16x8*)(lds + PG8_SB(b, h) + boff + n * 2048 + k * 1024); } while (0)
#define PG8_MMA(ai, bj, At, Bt) do { __builtin_amdgcn_s_setprio(1); _Pragma("unroll") for (int m = 0; m < 4; ++m) _Pragma("unroll") for (int n = 0; n < 2; ++n) _Pragma("unroll") for (int k = 0; k < 2; ++k) \
        acc[ai][bj][m][n] = __builtin_amdgcn_mfma_f32_16x16x32_bf16(Bt[n][k], At[m][k], acc[ai][bj][m][n], 0, 0, 0); __builtin_amdgcn_s_setprio(0); } while (0)
#define PG8_WAIT_V(n) asm volatile("s_waitcnt vmcnt(" #n ")" ::: "memory")
#define PG8_WAIT_L(n) asm volatile("s_waitcnt lgkmcnt(" #n ")" ::: "memory")
#define PG8_BAR __builtin_amdgcn_s_barrier()
#define PG8_SCHED __builtin_amdgcn_sched_barrier(0)
    Unit cur, nxt; int ui = 0;
    if (!S.next(0, cur)) return;
    f32x4 acc[2][2][4][2];
#pragma unroll
    for (int a = 0; a < 2; ++a)
#pragma unroll
        for (int b = 0; b < 2; ++b)
#pragma unroll
            for (int m = 0; m < 4; ++m)
#pragma unroll
                for (int n = 0; n < 2; ++n) acc[a][b][m][n] = (f32x4){0.f, 0.f, 0.f, 0.f};
    bf16x8 At[4][2], B0[2][2], B1[2][2];
    const char* cA = (const char*)g.A + (size_t)cur.pm * tstepA; const char* cB = (const char*)g.Bt + (size_t)cur.pn * tstepB;
    PG8_STAGE(PG8_SB(0, 0), cB, voffB); PG8_STAGE(PG8_SB(0, 1), cB + hstepB, voffB); PG8_STAGE(PG8_SA(0, 0), cA, voffA); PG8_STAGE(PG8_SA(0, 1), cA + hstepA, voffA);
    if (wr == 1) PG8_BAR;
    PG8_WAIT_V(2); PG8_BAR;
    PG8_STAGE(PG8_SB(1, 0), cB + kstep, voffB); PG8_STAGE(PG8_SA(1, 0), cA + kstep, voffA); PG8_STAGE(PG8_SB(1, 1), cB + hstepB + kstep, voffB);
    PG8_WAIT_V(6); PG8_BAR;
    for (;;) {
        const bool has_next = S.next(ui + 1, nxt);
        const char* nA = has_next ? (const char*)g.A + (size_t)nxt.pm * tstepA : cA; const char* nB = has_next ? (const char*)g.Bt + (size_t)nxt.pn * tstepB : cB;
        for (int t = 0; t < nt; t += 2) {
            const bool last = (t == nt - 2);
            const char* a1 = cA + (size_t)(t + 1) * kstep;
            const char* a2 = last ? nA : cA + (size_t)(t + 2) * kstep; const char* b2 = last ? nB : cB + (size_t)(t + 2) * kstep;
            const char* a3 = a2 + kstep; const char* b3 = b2 + kstep;
            PG8_LDB(B0, 0, 0); PG8_LDB(B1, 0, 1); PG8_SCHED; PG8_LDA(At, 0, 0); PG8_STAGE(PG8_SA(1, 1), a1 + hstepA, voffA);
            PG8_WAIT_V(8); PG8_WAIT_L(0); PG8_BAR; PG8_MMA(0, 0, At, B0); PG8_MMA(0, 1, At, B1); PG8_BAR; PG8_SCHED;
            PG8_LDA(At, 0, 1); PG8_STAGE(PG8_SB(0, 0), b2, voffB); PG8_STAGE(PG8_SB(0, 1), b2 + hstepB, voffB); PG8_STAGE(PG8_SA(0, 0), a2, voffA);
            PG8_WAIT_V(8); PG8_WAIT_L(0); PG8_BAR; PG8_MMA(1, 0, At, B0); PG8_MMA(1, 1, At, B1); PG8_BAR; PG8_SCHED;
            PG8_LDB(B0, 1, 0); PG8_LDB(B1, 1, 1); PG8_SCHED; PG8_LDA(At, 1, 0); PG8_STAGE(PG8_SA(0, 1), a2 + hstepA, voffA);
            PG8_WAIT_V(8); PG8_WAIT_L(0); PG8_BAR; PG8_MMA(0, 0, At, B0); PG8_MMA(0, 1, At, B1); PG8_BAR; PG8_SCHED;
            PG8_LDA(At, 1, 1); PG8_STAGE(PG8_SB(1, 0), b3, voffB); PG8_STAGE(PG8_SB(1, 1), b3 + hstepB, voffB); PG8_STAGE(PG8_SA(1, 0), a3, voffA);
            PG8_WAIT_V(8); PG8_WAIT_L(0); PG8_BAR; PG8_MMA(1, 0, At, B0); PG8_MMA(1, 1, At, B1); PG8_BAR; PG8_SCHED;
        }
#if PG8_ALIGN
        if (wr == 0) PG8_BAR;
#endif
        E(acc, cur, wr, wc, fr, fq);
        if (!has_next) break;
#pragma unroll
        for (int a = 0; a < 2; ++a)
#pragma unroll
            for (int b = 0; b < 2; ++b)
#pragma unroll
                for (int m = 0; m < 4; ++m)
#pragma unroll
                    for (int n = 0; n < 2; ++n) acc[a][b][m][n] = (f32x4){0.f, 0.f, 0.f, 0.f};
        cur = nxt; cA = nA; cB = nB; ++ui;
#if PG8_ALIGN
        if (wr == 1) PG8_BAR;
#endif
    }
    PG8_WAIT_V(0);
#if !PG8_ALIGN
    if (wr == 0) PG8_BAR;
#endif
    PG8_BAR;
#undef PG8_SA
#undef PG8_SB
#undef PG8_STAGE
#undef PG8_LDA
#undef PG8_LDB
#undef PG8_MMA
#undef PG8_WAIT_V
#undef PG8_WAIT_L
#undef PG8_BAR
#undef PG8_SCHED
}
}

#define MF(a, b, c) __builtin_amdgcn_mfma_f32_16x16x32_bf16((a), (b), (c), 0, 0, 0)
DI bf16x8 frag_nat(const LAS short* img, int stride, int row0, int k0, int fr, int fq) { return *(const LAS bf16x8*)(img + (row0 + fr) * stride + k0 + 8 * fq); }
DI bf16x8 frag_tr(const LAS short* img, int stride, int k0r, int col0, int fr, int fq) {
    const LAS short* p = img + (k0r + 8 * fq + (fr >> 2)) * stride + col0 + 4 * (fr & 3);
    const s16x4 lo = __builtin_amdgcn_ds_read_tr16_b64_v4i16((LAS s16x4*)p);
    const s16x4 hi = __builtin_amdgcn_ds_read_tr16_b64_v4i16((LAS s16x4*)(p + 4 * stride));
    return __builtin_shufflevector(lo, hi, 0, 1, 2, 3, 4, 5, 6, 7);
}
DI bf16x8 frag_glb(const bf16_t* g, int stride, int row0, int k0, int fr, int fq) { return *(const bf16x8*)(g + (size_t)(row0 + fr) * stride + k0 + 8 * fq); }


#define XB_TMO      128
#define XB_XCNT(j)  (256  + 64 * (j))
#define XB_XSUB(j)  (1280 + 64 * (j))
#define XB_XGEN(j)  (2304 + 64 * (j))
#define XB_TOP      3328
#define XB_TOPGEN   3392
#define XCD_BAR_WORDS 3456
#define XB_SPIN_CAP (1u << 22)
DI unsigned xb_ld(unsigned* p)              { return __hip_atomic_load(p, __ATOMIC_RELAXED, __HIP_MEMORY_SCOPE_AGENT); }
DI unsigned xb_add(unsigned* p, unsigned v) { return __hip_atomic_fetch_add(p, v, __ATOMIC_RELAXED, __HIP_MEMORY_SCOPE_AGENT); }
DI unsigned xb_xcc_id() { return (unsigned)__builtin_amdgcn_s_getreg((3 << 11) | 20) & 0xFu; }
#define XB_SPIN(cond, bar) do { unsigned _sp = 0; while (cond) { __builtin_amdgcn_s_sleep(1); \
    if ((++_sp & 255u) == 0u) { if (xb_ld(&(bar)[XB_TMO])) break; if (_sp > XB_SPIN_CAP) { atomicAdd(&(bar)[XB_TMO], 1u); break; } } } } while (0)
struct XcdBarrier { unsigned* bar; unsigned x; volatile LAS unsigned* st; };
DI XcdBarrier xcd_barrier_post(unsigned* bar, volatile LAS unsigned* st) {
    XcdBarrier b; b.bar = bar; b.x = xb_xcc_id(); b.st = st;
    if (threadIdx.x == 0) (void)xb_add(&bar[XB_XCNT(b.x)], 1u);
    return b;
}
DI void xcd_barrier_complete(unsigned* bar, unsigned x, unsigned& nloc, unsigned& nx) {
    const unsigned G = gridDim.x * gridDim.y * gridDim.z;
    unsigned sum, cnt, mine, sp = 0u;
    for (;;) {
        sum = 0u; cnt = 0u; mine = 0u;
#pragma unroll
        for (unsigned j = 0; j < 16; ++j) { const unsigned c = xb_ld(&bar[XB_XCNT(j)]); sum += c; cnt += (c > 0u) ? 1u : 0u; mine = (j == x) ? c : mine; }
        if (sum == G) break;
        __builtin_amdgcn_s_sleep(1);
        if ((++sp & 255u) == 0u) { if (xb_ld(&bar[XB_TMO])) break; if (sp > XB_SPIN_CAP) { atomicAdd(&bar[XB_TMO], 1u); break; } }
    }
    nloc = mine > 0u ? mine : 1u; nx = cnt > 0u ? cnt : 1u;
}
DI void xcd_barrier(const XcdBarrier& b) {
    asm volatile("s_waitcnt vmcnt(0)" ::: "memory");
    __syncthreads();
    if (threadIdx.x == 0) {
        unsigned* bar = b.bar;
        __builtin_amdgcn_s_waitcnt(0);
        unsigned nloc = b.st[0], nx = b.st[1];
        if (nloc == 0u) { xcd_barrier_complete(bar, b.x, nloc, nx); b.st[0] = nloc; b.st[1] = nx; }
        const unsigned old = xb_add(&bar[XB_XSUB(b.x)], 1u);
        const unsigned gen = old / nloc;
        if (old + 1u == (gen + 1u) * nloc) {
            __builtin_amdgcn_fence(__ATOMIC_RELEASE, "agent");
            asm volatile("s_waitcnt vmcnt(0)" ::: "memory");
            const unsigned og = xb_add(&bar[XB_TOP], 1u);
            const unsigned tg = og / nx;
            if (og + 1u == (tg + 1u) * nx) xb_add(&bar[XB_TOPGEN], 1u);
            else XB_SPIN(xb_ld(&bar[XB_TOPGEN]) == tg, bar);
            __builtin_amdgcn_fence(__ATOMIC_ACQUIRE, "agent");
            xb_add(&bar[XB_XGEN(b.x)], 1u);
            asm volatile("s_waitcnt vmcnt(0)" ::: "memory");
        } else {
            XB_SPIN(xb_ld(&bar[XB_XGEN(b.x)]) == gen, bar);
            __builtin_amdgcn_fence(__ATOMIC_ACQUIRE, "agent");
            asm volatile("s_waitcnt vmcnt(0)" ::: "memory");
        }
    }
    __syncthreads();
}

struct Ctx {
    const float* in[16]; float* out; unsigned char* ws;
    int tid, lane, wave, G, bx;
};

DI void transpose_item(const float* W, int K, int N, bf16_t* WT, int k0, int n0, int drow0, LAS float* scr, int lane) {
    float wv[32];
#pragma unroll
    for (int i = 0; i < 32; ++i) wv[i] = W[(size_t)(k0 + 2 * i + (lane >> 5)) * N + n0 + (lane & 31)];
    __builtin_amdgcn_sched_barrier(0);
#pragma unroll
    for (int i = 0; i < 32; ++i) scr[(2 * i + (lane >> 5)) * 33 + (lane & 31)] = wv[i];
    asm volatile("s_waitcnt lgkmcnt(0)" ::: "memory");
    const int c = lane & 7;
#pragma unroll
    for (int j = 0; j < 4; ++j) { const int n = (lane >> 3) + 8 * j; const LAS float* s = scr + (8 * c) * 33 + n;
        u32x4 o; o.x = cvt_pk_bf16(s[0 * 33], s[1 * 33]); o.y = cvt_pk_bf16(s[2 * 33], s[3 * 33]); o.z = cvt_pk_bf16(s[4 * 33], s[5 * 33]); o.w = cvt_pk_bf16(s[6 * 33], s[7 * 33]);
        *(u32x4*)(WT + (size_t)(drow0 + n) * K + k0 + 8 * c) = o; }
    asm volatile("s_waitcnt lgkmcnt(0)" ::: "memory");
}
DI void convert_ffn_item(int it, const float* Wg, const float* Wu, const float* Wd, bf16_t* WGU, bf16_t* WDt, LAS float* scr, int lane) {
    constexpr int NB = FF / 32;
    if (it < 2 * 5632) {
        const bool up = it >= 5632; const int r = up ? it - 5632 : it; const int kb = r / NB, nb = r % NB, n0 = nb * 32;
        const int drow = (n0 >> 7) * 256 + (n0 & 127) + (up ? 128 : 0);
        transpose_item(up ? Wu : Wg, D, FF, WGU, kb * 64, n0, drow, scr, lane);
    } else {
        const int r = it - 2 * 5632; const int kb = r / (D / 32), nb = r % (D / 32);
        transpose_item(Wd, FF, D, WDt, kb * 64, nb * 32, nb * 32, scr, lane);
    }
}
DI int win_perm_seg(int s) { return s == 0 ? 0 : s == 1 ? 2 : s == 2 ? 3 : s == 3 ? 4 : s == 4 ? 1 : s; }

DI void phase_prologue(Ctx& C, LAS unsigned char* lds) {
    LAS float* scr = (LAS float*)(lds + C.wave * 16384);
    const int gw = C.bx * NWAVES + C.wave, NGW = C.G * NWAVES;
    bf16_t* WGU = (bf16_t*)(C.ws + WS_WGU); bf16_t* WDt = (bf16_t*)(C.ws + WS_WD); bf16_t* WIN = (bf16_t*)(C.ws + WS_WIN); bf16_t* WOUT = (bf16_t*)(C.ws + WS_WOUT);
    constexpr int I_FFN = 3 * 5632, I_IN = 32 * 256, I_OUT = 32 * 64;
    for (int it = gw; it < I_FFN + I_IN + I_OUT; it += NGW) {
        if (it < I_FFN) { convert_ffn_item(it, C.in[2], C.in[3], C.in[4], WGU, WDt, scr, C.lane); continue; }
        int r = it - I_FFN;
        if (r < I_IN) { const int kb = r / 256, nb = r % 256, n0 = nb * 32; const int drow = win_perm_seg(n0 >> 10) * 1024 + (n0 & 1023);
            transpose_item(C.in[6], D, NIN, WIN, kb * 64, n0, drow, scr, C.lane); continue; }
        r -= I_IN; { const int kb = r / 64, nb = r % 64; transpose_item(C.in[10], D, D, WOUT, kb * 64, nb * 32, nb * 32, scr, C.lane); }
    }
    const float* g1 = C.in[1]; bf16_t* XN = (bf16_t*)(C.ws + WS_XN);
    f32x4 g1v[8];
#pragma unroll
    for (int j = 0; j < 8; ++j) g1v[j] = *((const f32x4*)g1 + 64 * j + C.lane);
    {
        f32x4 v[8], nv[8];
        if (gw < M) {
#pragma unroll
            for (int j = 0; j < 8; ++j) v[j] = *((const f32x4*)(C.in[0] + (size_t)gw * D) + C.lane + 64 * j);
        }
        for (int m = gw; m < M; m += NGW) {
            const int mn = (m + NGW < M) ? m + NGW : m;
#pragma unroll
            for (int j = 0; j < 8; ++j) nv[j] = *((const f32x4*)(C.in[0] + (size_t)mn * D) + C.lane + 64 * j);
            __builtin_amdgcn_sched_barrier(0);
            float s = 0.f;
#pragma unroll
            for (int j = 0; j < 8; ++j) s += (v[j][0] * v[j][0] + v[j][1] * v[j][1]) + (v[j][2] * v[j][2] + v[j][3] * v[j][3]);
            const float rs = 1.f / sqrtf(wave_sum(s) * (1.f / D) + EPS);
            u32x2* o8 = (u32x2*)(XN + (size_t)m * D) + C.lane;
#pragma unroll
            for (int j = 0; j < 8; ++j) { const f32x4 gg = g1v[j]; u32x2 w; w.x = cvt_pk_bf16(v[j][0] * rs * gg[0], v[j][1] * rs * gg[1]); w.y = cvt_pk_bf16(v[j][2] * rs * gg[2], v[j][3] * rs * gg[3]); o8[64 * j] = w; }
            __builtin_amdgcn_sched_barrier(0);
#pragma unroll
            for (int j = 0; j < 8; ++j) v[j] = nv[j];
        }
    }
    float* ssb = (float*)(C.ws + WS_SS1);
    for (int i = C.bx * NTHR + C.tid; i < 3 * M; i += C.G * NTHR) ssb[i] = 0.f;
}

DI void ret_pass_a(Ctx& C, LAS unsigned char* lds, int unit) {
    const bf16_t* P = (const bf16_t*)(C.ws + WS_PROJ); bf16_t* RS = (bf16_t*)(C.ws + WS_RS) + (size_t)unit * 65536;
    int tid_l = threadIdx.x; asm volatile("" : "+v"(tid_l));
    const int lane_l = tid_l & 63;
    const int h = unit & 3, bn = unit >> 2, row0 = bn * 128, fr = lane_l & 15, fq = lane_l >> 4, w = C.wave;
    LAS short* Vi = (LAS short*)lds; LAS short* Ki = Vi + 128 * 264;
    const float lg = __logf(1.f - exp2f(-5.f - (float)h));
    u32x4 kst[8], vst[8];
#pragma unroll
    for (int it = 0; it < 8; ++it) { const int c = it * NTHR + tid_l, r = c >> 5, ch = c & 31; const bf16_t* src = P + (size_t)(row0 + r) * PP + h * 256 + ch * 8;
        vst[it] = *(const u32x4*)(src + COL_RV); kst[it] = *(const u32x4*)(src + COL_RK); }
#pragma unroll
    for (int it = 0; it < 8; ++it) {
        const int c = it * NTHR + tid_l, r = c >> 5, ch = c & 31;
        const u32x4 vv = vst[it]; const u32x4 kk = kst[it];
        const float dc = __expf(lg * (float)(127 - r));
        u32x4 ko; ko.x = cvt_pk_bf16(bflo(kk.x) * dc, bfhi(kk.x) * dc); ko.y = cvt_pk_bf16(bflo(kk.y) * dc, bfhi(kk.y) * dc); ko.z = cvt_pk_bf16(bflo(kk.z) * dc, bfhi(kk.z) * dc); ko.w = cvt_pk_bf16(bflo(kk.w) * dc, bfhi(kk.w) * dc);
        *(LAS u32x4*)(Vi + r * 264 + ch * 8) = vv; *(LAS u32x4*)(Ki + r * 264 + ch * 8) = ko;
    }
    __syncthreads();
    for (int db = 0; db < 4; ++db) {
        f32x4 acc[2][4];
#pragma unroll
        for (int a = 0; a < 2; ++a)
#pragma unroll
            for (int b = 0; b < 4; ++b) acc[a][b] = (f32x4){0.f, 0.f, 0.f, 0.f};
#pragma unroll
        for (int ks = 0; ks < 4; ++ks) {
            bf16x8 vf[2], kf[4];
#pragma unroll
            for (int et = 0; et < 2; ++et) vf[et] = frag_tr(Vi, 264, 32 * ks, 32 * w + 16 * et, fr, fq);
#pragma unroll
            for (int dt = 0; dt < 4; ++dt) kf[dt] = frag_tr(Ki, 264, 32 * ks, 64 * db + 16 * dt, fr, fq);
            __builtin_amdgcn_sched_barrier(0);
#pragma unroll
            for (int et = 0; et < 2; ++et)
#pragma unroll
                for (int dt = 0; dt < 4; ++dt) acc[et][dt] = MF(kf[dt], vf[et], acc[et][dt]);
        }
#pragma unroll
        for (int et = 0; et < 2; ++et)
#pragma unroll
            for (int dt = 0; dt < 4; ++dt) { u32x2 o; o.x = cvt_pk_bf16(acc[et][dt][0], acc[et][dt][1]); o.y = cvt_pk_bf16(acc[et][dt][2], acc[et][dt][3]);
                *(u32x2*)(RS + (size_t)(32 * w + 16 * et + fr) * 256 + 64 * db + 16 * dt + 4 * fq) = o; }
    }
    __syncthreads();
}

struct HPrep { float cum[16]; float kk[16]; float off, total, cmid; };
DI void hgrn_prep(Ctx& C, LAS float* segtot, const bf16_t* P, int row0, int h, HPrep& hp) {
    const int d = C.tid & 127, seg = C.tid >> 7;
    const float lbl = C.in[8][h * 128 + d]; const float lbv = __builtin_amdgcn_rcpf(1.f + __expf(-lbl)), oml = 1.f - lbv;
    float run = 0.f;
#pragma unroll
    for (int r = 0; r < 16; ++r) {
        float z = bf2f(P[(size_t)(row0 + 16 * seg + r) * PP + COL_HF + h * 128 + d]); z = fminf(fmaxf(z, -30.f), 30.f);
        const float e = __expf(-z), sg = __builtin_amdgcn_rcpf(1.f + e), f = lbv + oml * sg;
        run += __logf(f); hp.cum[r] = run; hp.kk[r] = oml * e * sg;
    }
    segtot[seg * 128 + d] = run;
    __syncthreads();
    const float t0 = segtot[d], t1 = segtot[128 + d], t2 = segtot[256 + d], t3 = segtot[384 + d];
    hp.off = seg == 0 ? 0.f : seg == 1 ? t0 : seg == 2 ? t0 + t1 : t0 + t1 + t2;
    hp.total = (t0 + t1) + (t2 + t3); hp.cmid = t0 + t1;
}
DI void hgrn_pass_a(Ctx& C, LAS unsigned char* lds, int unit) {
    const bf16_t* P = (const bf16_t*)(C.ws + WS_PROJ); bf16_t* HS = (bf16_t*)(C.ws + WS_HS) + (size_t)unit * 16384; float* DEC = (float*)(C.ws + WS_DEC) + (size_t)unit * 128;
    const int h = unit & 7, bn = unit >> 3, row0 = bn * 64, fr = C.lane & 15, fq = C.lane >> 4, w = C.wave;
    LAS short* Vi = (LAS short*)lds; LAS short* Ki = Vi + 64 * 136; LAS float* segtot = (LAS float*)(Ki + 64 * 136);
    const int d = C.tid & 127, seg = C.tid >> 7;
#pragma unroll
    for (int it = 0; it < 2; ++it) { const int c = it * NTHR + C.tid, r = c >> 4, ch = c & 15;
        *(LAS u32x4*)(Vi + r * 136 + ch * 8) = *(const u32x4*)(P + (size_t)(row0 + r) * PP + COL_HI + h * 128 + ch * 8); }
    HPrep hp; hgrn_prep(C, segtot, P, row0, h, hp);
#pragma unroll
    for (int r = 0; r < 16; ++r) { const float c = hp.cum[r] + hp.off; const float kd = hp.kk[r] * __expf(hp.total - c);
        Ki[(16 * seg + r) * 136 + d] = (short)(cvt_pk_bf16(kd, 0.f) & 0xffffu); }
    if (seg == 0) DEC[d] = __expf(hp.total);
    __syncthreads();
    f32x4 acc[8];
#pragma unroll
    for (int b = 0; b < 8; ++b) acc[b] = (f32x4){0.f, 0.f, 0.f, 0.f};
#pragma unroll
    for (int ks = 0; ks < 2; ++ks) {
        const bf16x8 vf = frag_tr(Vi, 136, 32 * ks, 16 * w, fr, fq);
#pragma unroll
        for (int dt = 0; dt < 8; ++dt) { const bf16x8 kf = frag_tr(Ki, 136, 32 * ks, 16 * dt, fr, fq); acc[dt] = MF(kf, vf, acc[dt]); }
    }
#pragma unroll
    for (int dt = 0; dt < 8; ++dt) { u32x2 o; o.x = cvt_pk_bf16(acc[dt][0], acc[dt][1]); o.y = cvt_pk_bf16(acc[dt][2], acc[dt][3]);
        *(u32x2*)(HS + (size_t)(16 * w + fr) * 128 + 16 * dt + 4 * fq) = o; }
    __syncthreads();
}

struct HPrep2 { float cum[32]; float kk[32]; float off, total; };
DI void hgrn_prep2(Ctx& C, LAS float* segtot, const bf16_t* P, int row0, int hp, int tid_l, HPrep2& hp2) {
    const int d2 = tid_l & 255, seg = tid_l >> 8;
    const float lbl = C.in[8][hp * 256 + d2]; const float lbv = __builtin_amdgcn_rcpf(1.f + __expf(-lbl)), oml = 1.f - lbv;
    unsigned short zr[32];
#pragma unroll
    for (int r = 0; r < 32; ++r) zr[r] = P[(size_t)(row0 + 32 * seg + r) * PP + COL_HF + hp * 256 + d2];
    __builtin_amdgcn_sched_barrier(0);
    float run = 0.f;
#pragma unroll
    for (int r = 0; r < 32; ++r) {
        float z = bf2f(zr[r]); z = fminf(fmaxf(z, -30.f), 30.f);
        const float e = __expf(-z), sg = __builtin_amdgcn_rcpf(1.f + e), f = lbv + oml * sg;
        run += __logf(f); hp2.cum[r] = run; hp2.kk[r] = oml * e * sg;
    }
    segtot[seg * 256 + d2] = run;
    __syncthreads();
    const float t0 = segtot[d2], t1 = segtot[256 + d2];
    hp2.off = seg == 0 ? 0.f : t0; hp2.total = t0 + t1;
}
DI void hgrn_pass_a2(Ctx& C, LAS unsigned char* lds, int pu) {
    const bf16_t* P = (const bf16_t*)(C.ws + WS_PROJ);
    int tid_l = threadIdx.x; asm volatile("" : "+v"(tid_l));
    const int lane_l = tid_l & 63, hp = pu & 3, bn = pu >> 2, row0 = bn * 64, fr = lane_l & 15, fq = lane_l >> 4, w = C.wave;
    LAS short* Vi = (LAS short*)lds; LAS short* Ki = Vi + 64 * 264; LAS float* segtot = (LAS float*)(Ki + 64 * 264);
    const int d2 = tid_l & 255, seg = tid_l >> 8;
    u32x4 vst[4];
#pragma unroll
    for (int it = 0; it < 4; ++it) { const int c = it * NTHR + tid_l, r = c >> 5, ch = c & 31; vst[it] = *(const u32x4*)(P + (size_t)(row0 + r) * PP + COL_HI + hp * 256 + ch * 8); }
    HPrep2 h2; hgrn_prep2(C, segtot, P, row0, hp, tid_l, h2);
#pragma unroll
    for (int it = 0; it < 4; ++it) { const int c = it * NTHR + tid_l, r = c >> 5, ch = c & 31; *(LAS u32x4*)(Vi + r * 264 + ch * 8) = vst[it]; }
#pragma unroll
    for (int r = 0; r < 32; ++r) { const float c = h2.cum[r] + h2.off; Ki[(32 * seg + r) * 264 + d2] = (short)(cvt_pk_bf16(h2.kk[r] * __expf(h2.total - c), 0.f) & 0xffffu); }
    if (seg == 0) ((float*)(C.ws + WS_DEC))[(size_t)(bn * 8 + 2 * hp + (d2 >> 7)) * 128 + (d2 & 127)] = __expf(h2.total);
    __syncthreads();
#pragma unroll
    for (int hd = 0; hd < 2; ++hd) {
        bf16_t* HS = (bf16_t*)(C.ws + WS_HS) + (size_t)(bn * 8 + 2 * hp + hd) * 16384;
        f32x4 acc[8];
#pragma unroll
        for (int b = 0; b < 8; ++b) acc[b] = (f32x4){0.f, 0.f, 0.f, 0.f};
#pragma unroll
        for (int ks = 0; ks < 2; ++ks) {
            const bf16x8 vf = frag_tr(Vi, 264, 32 * ks, 128 * hd + 16 * w, fr, fq);
            bf16x8 kf[8];
#pragma unroll
            for (int dt = 0; dt < 8; ++dt) kf[dt] = frag_tr(Ki, 264, 32 * ks, 128 * hd + 16 * dt, fr, fq);
            __builtin_amdgcn_sched_barrier(0);
#pragma unroll
            for (int dt = 0; dt < 8; ++dt) acc[dt] = MF(kf[dt], vf, acc[dt]);
        }
#pragma unroll
        for (int dt = 0; dt < 8; ++dt) { u32x2 o; o.x = cvt_pk_bf16(acc[dt][0], acc[dt][1]); o.y = cvt_pk_bf16(acc[dt][2], acc[dt][3]);
            *(u32x2*)(HS + (size_t)(16 * w + fr) * 128 + 16 * dt + 4 * fq) = o; }
    }
    __syncthreads();
}
template <int SK> DI void hgrn_pass_c2(Ctx& C, LAS unsigned char* lds, int pu) {
    bf16_t* P = (bf16_t*)(C.ws + WS_PROJ);
    int tid_l = threadIdx.x; asm volatile("" : "+v"(tid_l));
    const int lane_l = tid_l & 63, hp = pu & 3, bn = pu >> 2, row0 = bn * 64, fr = lane_l & 15, fq = lane_l >> 4, w = C.wave;
    LAS short* Qt = (LAS short*)lds; LAS short* Kt = Qt + 64 * 264; LAS short* Vi = Kt + 64 * 264;
    LAS float* segtot = (LAS float*)(Vi + 64 * 264); LAS float* ssx = segtot + 512; LAS short* Sw = (LAS short*)(ssx + 256) + w * 16 * 72;
    const int d2 = tid_l & 255, seg = tid_l >> 8;
    const int rb = w & 3, eh = w >> 2, t0 = 16 * rb, trow = t0 + fr;
    u32x4 vst[4];
#pragma unroll
    for (int it = 0; it < 4; ++it) { const int c = it * NTHR + tid_l, r = c >> 5, ch = c & 31; vst[it] = *(const u32x4*)(P + (size_t)(row0 + r) * PP + COL_HI + hp * 256 + ch * 8); }
    unsigned short qr[32];
#pragma unroll
    for (int r = 0; r < 32; ++r) qr[r] = P[(size_t)(row0 + 32 * seg + r) * PP + COL_HQ + hp * 256 + d2];
    u32x2 sgv[2][4];
#pragma unroll
    for (int hd = 0; hd < 2; ++hd)
#pragma unroll
        for (int et = 0; et < 4; ++et) sgv[hd][et] = *(const u32x2*)(P + (size_t)(row0 + trow) * PP + COL_HG + hp * 256 + 128 * hd + 64 * eh + 16 * et + 4 * fq);
    f32x4 ggv[2][4];
#pragma unroll
    for (int hd = 0; hd < 2; ++hd)
#pragma unroll
        for (int et = 0; et < 4; ++et) ggv[hd][et] = *(const f32x4*)(C.in[9] + hp * 256 + 128 * hd + 64 * eh + 16 * et + 4 * fq);
    HPrep2 h2; hgrn_prep2(C, segtot, P, row0, hp, tid_l, h2);
#pragma unroll
    for (int it = 0; it < 4; ++it) { const int c = it * NTHR + tid_l, r = c >> 5, ch = c & 31; *(LAS u32x4*)(Vi + r * 264 + ch * 8) = vst[it]; }
#pragma unroll
    for (int r = 0; r < 32; ++r) {
        const float c = h2.cum[r] + h2.off; const int a = (32 * seg + r) * 264 + d2;
        if (!(SK & 2)) { Qt[a] = (short)(cvt_pk_bf16(bf2f(qr[r]) * __expf(c), 0.f) & 0xffffu);
        Kt[a] = (short)(cvt_pk_bf16(h2.kk[r] * __expf(-c), 0.f) & 0xffffu); }
    }
    __syncthreads();
    f32x4 oo[2][4];
    bf16x8 hsf[4][4];
    {   const bf16_t* HS0 = (const bf16_t*)(C.ws + WS_HS) + (size_t)(bn * 8 + 2 * hp) * 16384;
#pragma unroll
        for (int ks = 0; ks < 4; ++ks)
#pragma unroll
            for (int et = 0; et < 4; ++et) hsf[ks][et] = frag_glb(HS0, 128, 64 * eh + 16 * et, 32 * ks, fr, fq);
        __builtin_amdgcn_sched_barrier(0); }
#pragma unroll
    for (int hd = 0; hd < 2; ++hd) {
        if (SK & 1) { for (int et = 0; et < 4; ++et) oo[hd][et] = (f32x4){1.f, 1.f, 1.f, 1.f}; continue; }
        bf16x8 qf[4];
#pragma unroll
        for (int ks = 0; ks < 4; ++ks) qf[ks] = frag_nat(Qt, 264, t0, 128 * hd + 32 * ks, fr, fq);
#pragma unroll
        for (int jt = 0; jt < 4; ++jt) {
            u32x2 sp = (u32x2){0u, 0u};
            if (jt <= rb) {
                f32x4 a = (f32x4){0.f, 0.f, 0.f, 0.f};
                bf16x8 kf[4];
#pragma unroll
                for (int ks = 0; ks < 4; ++ks) kf[ks] = frag_nat(Kt, 264, 16 * jt, 128 * hd + 32 * ks, fr, fq);
                __builtin_amdgcn_sched_barrier(0);
#pragma unroll
                for (int ks = 0; ks < 4; ++ks) a = MF(kf[ks], qf[ks], a);
                float v[4];
#pragma unroll
                for (int r = 0; r < 4; ++r) { const int j = 16 * jt + 4 * fq + r; v[r] = (j <= trow) ? a[r] : 0.f; }
                sp.x = cvt_pk_bf16(v[0], v[1]); sp.y = cvt_pk_bf16(v[2], v[3]);
            }
            *(LAS u32x2*)(Sw + fr * 72 + 16 * jt + 4 * fq) = sp;
        }
        f32x4 o[4];
#pragma unroll
        for (int et = 0; et < 4; ++et) o[et] = (f32x4){0.f, 0.f, 0.f, 0.f};
#pragma unroll
        for (int ks = 0; ks < 4; ++ks)
#pragma unroll
            for (int et = 0; et < 4; ++et) o[et] = MF(hsf[ks][et], qf[ks], o[et]);
        if (hd == 0) {
            __builtin_amdgcn_sched_barrier(0);
            const bf16_t* HS1 = (const bf16_t*)(C.ws + WS_HS) + (size_t)(bn * 8 + 2 * hp + 1) * 16384;
#pragma unroll
            for (int ks = 0; ks < 4; ++ks)
#pragma unroll
                for (int et = 0; et < 4; ++et) hsf[ks][et] = frag_glb(HS1, 128, 64 * eh + 16 * et, 32 * ks, fr, fq);
            __builtin_amdgcn_sched_barrier(0);
        }
#pragma unroll
        for (int ks = 0; ks < 2; ++ks) {
            const bf16x8 sf = frag_nat(Sw, 72, 0, 32 * ks, fr, fq);
            bf16x8 vf[4];
#pragma unroll
            for (int et = 0; et < 4; ++et) vf[et] = frag_tr(Vi, 264, 32 * ks, 128 * hd + 64 * eh + 16 * et, fr, fq);
            __builtin_amdgcn_sched_barrier(0);
#pragma unroll
            for (int et = 0; et < 4; ++et) o[et] = MF(vf[et], sf, o[et]);
        }
        float ss = 0.f;
#pragma unroll
        for (int et = 0; et < 4; ++et) { ss += (o[et][0] * o[et][0] + o[et][1] * o[et][1]) + (o[et][2] * o[et][2] + o[et][3] * o[et][3]); oo[hd][et] = o[et]; }
        ss += __shfl_xor(ss, 16); ss += __shfl_xor(ss, 32);
        if (fq == 0) ssx[(hd * 2 + eh) * 64 + trow] = ss;
    }
    __syncthreads();
#pragma unroll
    for (int hd = 0; hd < 2; ++hd) {
        const float rstd = __builtin_amdgcn_rsqf((ssx[(hd * 2) * 64 + trow] + ssx[(hd * 2 + 1) * 64 + trow]) * (1.f / 128.f) + EPS);
        const float* gn = C.in[9] + hp * 256 + 128 * hd; bf16_t* prow = P + (size_t)(row0 + trow) * PP + COL_HQ + hp * 256 + 128 * hd;
#pragma unroll
        for (int et = 0; et < 4; ++et) {
            const int e = 64 * eh + 16 * et + 4 * fq; const f32x4 gg = ggv[hd][et]; const u32x2 sg = sgv[hd][et];
            const f32x4 y = oo[hd][et] * rstd * gg;
            u32x2 ov; ov.x = cvt_pk_bf16(y[0] * bflo(sg.x), y[1] * bfhi(sg.x)); ov.y = cvt_pk_bf16(y[2] * bflo(sg.y), y[3] * bfhi(sg.y));
            if (!(SK & 8) || ov.x == 0xDEADBEEFu) *(u32x2*)(prow + e) = ov;
        }
    }
    __syncthreads();
}

template <bool DUMMY> DI void scan_item(Ctx& C, int item) {
    u32x4* dq = (u32x4*)(C.ws + WS_END) + (threadIdx.x + blockIdx.x * NTHR) ;
    if (item < 65536) {
        const int bh = item >> 13, off = (item & 8191) * 8, b = bh >> 2, h = bh & 3;
        bf16_t* p = (bf16_t*)(C.ws + WS_RS) + ((size_t)(b * 64) * 4 + h) * 65536 + off;
        const float g = __expf(128.f * __logf(1.f - exp2f(-5.f - (float)h)));
        float s[8];
#pragma unroll
        for (int i = 0; i < 8; ++i) s[i] = 0.f;
        for (int n0 = 0; n0 < 64; n0 += 16) {
            u32x4 tv[16];
#pragma unroll
            for (int k = 0; k < 16; ++k) tv[k] = *(const u32x4*)(p + (size_t)(n0 + k) * 4 * 65536);
            __builtin_amdgcn_sched_barrier(0);
#pragma unroll
            for (int k = 0; k < 16; ++k) {
                u32x4* q = (u32x4*)(p + (size_t)(n0 + k) * 4 * 65536); const u32x4 t = tv[k];
                u32x4 o; o.x = cvt_pk_bf16(s[0], s[1]); o.y = cvt_pk_bf16(s[2], s[3]); o.z = cvt_pk_bf16(s[4], s[5]); o.w = cvt_pk_bf16(s[6], s[7]); if (DUMMY) *dq = o; else *q = o;
                s[0] = g * s[0] + bflo(t.x); s[1] = g * s[1] + bfhi(t.x); s[2] = g * s[2] + bflo(t.y); s[3] = g * s[3] + bfhi(t.y);
                s[4] = g * s[4] + bflo(t.z); s[5] = g * s[5] + bfhi(t.z); s[6] = g * s[6] + bflo(t.w); s[7] = g * s[7] + bfhi(t.w);
            }
            __builtin_amdgcn_sched_barrier(0);
        }
    } else {
        const int it = item - 65536, bh = it >> 11, off = (it & 2047) * 8, b = bh >> 3, h = bh & 7, d0 = off & 127;
        bf16_t* p = (bf16_t*)(C.ws + WS_HS) + ((size_t)(b * 128) * 8 + h) * 16384 + off;
        const float* dp = (const float*)(C.ws + WS_DEC) + ((size_t)(b * 128) * 8 + h) * 128 + d0;
        float s[8];
#pragma unroll
        for (int i = 0; i < 8; ++i) s[i] = 0.f;
        for (int n0 = 0; n0 < 128; n0 += 8) {
            u32x4 tv[8]; f32x4 g0[8], g1[8];
#pragma unroll
            for (int k = 0; k < 8; ++k) { tv[k] = *(const u32x4*)(p + (size_t)(n0 + k) * 8 * 16384);
                g0[k] = *(const f32x4*)(dp + (size_t)(n0 + k) * 8 * 128); g1[k] = *(const f32x4*)(dp + (size_t)(n0 + k) * 8 * 128 + 4); }
            __builtin_amdgcn_sched_barrier(0);
#pragma unroll
            for (int k = 0; k < 8; ++k) {
                u32x4* q = (u32x4*)(p + (size_t)(n0 + k) * 8 * 16384); const u32x4 t = tv[k];
                u32x4 o; o.x = cvt_pk_bf16(s[0], s[1]); o.y = cvt_pk_bf16(s[2], s[3]); o.z = cvt_pk_bf16(s[4], s[5]); o.w = cvt_pk_bf16(s[6], s[7]); if (DUMMY) *dq = o; else *q = o;
                s[0] = g0[k][0] * s[0] + bflo(t.x); s[1] = g0[k][1] * s[1] + bfhi(t.x); s[2] = g0[k][2] * s[2] + bflo(t.y); s[3] = g0[k][3] * s[3] + bfhi(t.y);
                s[4] = g1[k][0] * s[4] + bflo(t.z); s[5] = g1[k][1] * s[5] + bfhi(t.z); s[6] = g1[k][2] * s[6] + bflo(t.w); s[7] = g1[k][3] * s[7] + bfhi(t.w);
            }
            __builtin_amdgcn_sched_barrier(0);
        }
    }
}

template <int SKIP> DI void ret_pass_c(Ctx& C, LAS unsigned char* lds, int unit, bf16_t* Pdst, int rowmask) {
    bf16_t* P = (bf16_t*)(C.ws + WS_PROJ); const bf16_t* RS = (const bf16_t*)(C.ws + WS_RS) + (size_t)unit * 65536;
    int tid_l = threadIdx.x; asm volatile("" : "+v"(tid_l));
    const int lane_l = tid_l & 63;
    const int h = unit & 3, bn = unit >> 2, row0 = bn * 128, fr = lane_l & 15, fq = lane_l >> 4, w = C.wave, i0 = 16 * w;
    LAS short* Ki = (LAS short*)lds; LAS short* Vi = Ki + 128 * 264; LAS float* part = (LAS float*)(Vi + 128 * 264);
    const float lg = __logf(1.f - exp2f(-5.f - (float)h));
    const bf16_t* Qg = P + COL_RQ + h * 256;
    u32x2 sp[8];
    {
        bf16x8 qf[8];
        {
            u32x4 kst[8], vst[8];
#pragma unroll
            for (int it = 0; it < 8; ++it) { const int c = it * NTHR + tid_l, r = c >> 5, ch = c & 31; const bf16_t* src = P + (size_t)(row0 + r) * PP + h * 256 + ch * 8;
                vst[it] = *(const u32x4*)(src + COL_RV); kst[it] = *(const u32x4*)(src + COL_RK); }
#pragma unroll
            for (int ks = 0; ks < 8; ++ks) qf[ks] = frag_glb(Qg, PP, row0 + i0, 32 * ks, fr, fq);
#pragma unroll
            for (int it = 0; it < 8; ++it) { const int c = it * NTHR + tid_l, r = c >> 5, ch = c & 31;
                *(LAS u32x4*)(Vi + r * 264 + ch * 8) = vst[it]; *(LAS u32x4*)(Ki + r * 264 + ch * 8) = kst[it]; }
        }
        __syncthreads();
        const int irow = i0 + fr;
#pragma unroll
        for (int jt = 0; jt < 8; ++jt) {
            sp[jt] = (u32x2){0u, 0u};
            if (!(SKIP & 4) && jt <= w) {
                f32x4 a = (f32x4){0.f, 0.f, 0.f, 0.f};
                bf16x8 kf[8];
#pragma unroll
                for (int ks = 0; ks < 8; ++ks) kf[ks] = frag_nat(Ki, 264, 16 * jt, 32 * ks, fr, fq);
                __builtin_amdgcn_sched_barrier(0);
#pragma unroll
                for (int ks = 0; ks < 8; ++ks) a = MF(kf[ks], qf[ks], a);
                float v[4];
#pragma unroll
                for (int r = 0; r < 4; ++r) { const int j = 16 * jt + 4 * fq + r; v[r] = (j <= irow) ? a[r] * __expf(lg * (float)(irow - j)) : 0.f; }
                sp[jt].x = cvt_pk_bf16(v[0], v[1]); sp[jt].y = cvt_pk_bf16(v[2], v[3]);
            }
        }
    }
    __syncthreads();
    LAS short* Si = Ki;
#pragma unroll
    for (int jt = 0; jt < 8; ++jt) *(LAS u32x2*)(Si + (i0 + fr) * 136 + 16 * jt + 4 * fq) = sp[jt];
    const int ri = w >> 2, ei = w & 3;
    f32x4 o[4][4];
#pragma unroll
    for (int rt = 0; rt < 4; ++rt)
#pragma unroll
        for (int et = 0; et < 4; ++et) o[rt][et] = (f32x4){0.f, 0.f, 0.f, 0.f};
    {
        bf16x8 fa[2][2][4], fb[2][2][4];
#define RC_LOAD(buf, bt) do { _Pragma("unroll") for (int k2 = 0; k2 < 2; ++k2) { _Pragma("unroll") for (int rt = 0; rt < 4; ++rt) fa[buf][k2][rt] = frag_glb(Qg, PP, row0 + 64 * ri + 16 * rt, 32 * (2 * (bt) + k2), fr, fq); \
            _Pragma("unroll") for (int et = 0; et < 4; ++et) fb[buf][k2][et] = frag_glb(RS, 256, 64 * ei + 16 * et, 32 * (2 * (bt) + k2), fr, fq); } } while (0)
        if (!(SKIP & 1)) {
            RC_LOAD(0, 0);
#pragma unroll
            for (int bt = 0; bt < 4; ++bt) {
                if (bt < 3) { if (bt & 1) RC_LOAD(0, bt + 1); else RC_LOAD(1, bt + 1); }
                __builtin_amdgcn_sched_barrier(0);
#pragma unroll
                for (int k2 = 0; k2 < 2; ++k2)
#pragma unroll
                    for (int rt = 0; rt < 4; ++rt)
#pragma unroll
                        for (int et = 0; et < 4; ++et) o[rt][et] = MF(fb[bt & 1][k2][et], fa[bt & 1][k2][rt], o[rt][et]);
                __builtin_amdgcn_sched_barrier(0);
            }
        }
#undef RC_LOAD
    }
#pragma unroll
    for (int rt = 0; rt < 4; ++rt) { const float qd = __expf(lg * (float)(64 * ri + 16 * rt + fr + 1));
#pragma unroll
        for (int et = 0; et < 4; ++et) o[rt][et] = o[rt][et] * qd; }
    __syncthreads();
#pragma unroll
    for (int ks = 0; ks < 4; ++ks) {
        if (!(SKIP & 2) && 32 * ks <= 64 * ri + 63) {
            bf16x8 sf[4], vf[4];
#pragma unroll
            for (int rt = 0; rt < 4; ++rt) sf[rt] = frag_nat(Si, 136, 64 * ri + 16 * rt, 32 * ks, fr, fq);
#pragma unroll
            for (int et = 0; et < 4; ++et) vf[et] = frag_tr(Vi, 264, 32 * ks, 64 * ei + 16 * et, fr, fq);
            __builtin_amdgcn_sched_barrier(0);
#pragma unroll
            for (int rt = 0; rt < 4; ++rt)
#pragma unroll
                for (int et = 0; et < 4; ++et) o[rt][et] = MF(vf[et], sf[rt], o[rt][et]);
        }
    }
#pragma unroll
    for (int rt = 0; rt < 4; ++rt) {
        float s = 0.f, q = 0.f;
#pragma unroll
        for (int et = 0; et < 4; ++et) { const f32x4 x = o[rt][et]; s += (x[0] + x[1]) + (x[2] + x[3]); q += (x[0] * x[0] + x[1] * x[1]) + (x[2] * x[2] + x[3] * x[3]); }
        s += __shfl_xor(s, 16); s += __shfl_xor(s, 32); q += __shfl_xor(q, 16); q += __shfl_xor(q, 32);
        if (fq == 0) { const int r = 64 * ri + 16 * rt + fr; part[(ei * 128 + r) * 2] = s; part[(ei * 128 + r) * 2 + 1] = q; }
    }
    u32x2 sgv[4][4];
#pragma unroll
    for (int rt = 0; rt < 4; ++rt)
#pragma unroll
        for (int et = 0; et < 4; ++et) sgv[rt][et] = *(const u32x2*)(P + (size_t)(row0 + 64 * ri + 16 * rt + fr) * PP + h * 256 + COL_RG + 64 * ei + 16 * et + 4 * fq);
    const float* gn = C.in[7] + h * 256;
    f32x4 ggv[4];
#pragma unroll
    for (int et = 0; et < 4; ++et) ggv[et] = *(const f32x4*)(gn + 64 * ei + 16 * et + 4 * fq);
    __builtin_amdgcn_sched_barrier(0);
    __syncthreads();
#pragma unroll
    for (int rt = 0; rt < 4; ++rt) {
        const int r = 64 * ri + 16 * rt + fr;
        float s = 0.f, q = 0.f;
#pragma unroll
        for (int e4 = 0; e4 < 4; ++e4) { s += part[(e4 * 128 + r) * 2]; q += part[(e4 * 128 + r) * 2 + 1]; }
        const float mu = s * (1.f / 256.f); const float rstd = __builtin_amdgcn_rsqf(fmaxf(q * (1.f / 256.f) - mu * mu, 0.f) + EPS);
        const bf16_t* prow = P + (size_t)(row0 + r) * PP + h * 256;
        bf16_t* drow = Pdst + (size_t)((row0 + r) & rowmask) * PP + h * 256 + COL_RQ;
#pragma unroll
        for (int et = 0; et < 4; ++et) {
            const int e = 64 * ei + 16 * et + 4 * fq; const f32x4 gg = ggv[et]; const u32x2 sg = sgv[rt][et];
            const f32x4 y = (o[rt][et] - mu) * rstd * gg;
            u32x2 ov; ov.x = cvt_pk_bf16(y[0] * bflo(sg.x), y[1] * bfhi(sg.x)); ov.y = cvt_pk_bf16(y[2] * bflo(sg.y), y[3] * bfhi(sg.y));
            if (rowmask != 511 || ov.x == 0xDEADBEEFu) *(u32x2*)(drow + e) = ov;
        }
    }
    __syncthreads();
}

DI void hgrn_pass_c(Ctx& C, LAS unsigned char* lds, int unit, bf16_t* Pdst, int rowmask) {
    bf16_t* P = (bf16_t*)(C.ws + WS_PROJ); const bf16_t* HS = (const bf16_t*)(C.ws + WS_HS) + (size_t)unit * 16384;
    const int h = unit & 7, bn = unit >> 3, row0 = bn * 64, fr = C.lane & 15, fq = C.lane >> 4, w = C.wave;
    LAS short* Qt = (LAS short*)lds; LAS short* Kt = Qt + 64 * 136; LAS short* Qc = Kt + 64 * 136; LAS short* Vi = Qc + 64 * 136;
    LAS float* segtot = (LAS float*)(Vi + 64 * 136); LAS float* ssx = segtot + 512; LAS short* Sw = (LAS short*)(ssx + 128) + w * 16 * 72;
    const int d = C.tid & 127, seg = C.tid >> 7;
#pragma unroll
    for (int it = 0; it < 2; ++it) { const int c = it * NTHR + C.tid, r = c >> 4, ch = c & 15;
        *(LAS u32x4*)(Vi + r * 136 + ch * 8) = *(const u32x4*)(P + (size_t)(row0 + r) * PP + COL_HI + h * 128 + ch * 8); }
    float qv[16];
#pragma unroll
    for (int r = 0; r < 16; ++r) qv[r] = bf2f(P[(size_t)(row0 + 16 * seg + r) * PP + COL_HQ + h * 128 + d]);
    const int rb = w & 3, eh = w >> 2, t0 = 16 * rb, trow = t0 + fr;
    bf16x8 hsf[4][4];
#pragma unroll
    for (int ks = 0; ks < 4; ++ks)
#pragma unroll
        for (int et = 0; et < 4; ++et) hsf[ks][et] = frag_glb(HS, 128, 64 * eh + 16 * et, 32 * ks, fr, fq);
    u32x2 sgv[4];
#pragma unroll
    for (int et = 0; et < 4; ++et) sgv[et] = *(const u32x2*)(P + (size_t)(row0 + trow) * PP + h * 128 + COL_HG + 64 * eh + 16 * et + 4 * fq);
    HPrep hp; hgrn_prep(C, segtot, P, row0, h, hp);
#pragma unroll
    for (int r = 0; r < 16; ++r) {
        const float c = hp.cum[r] + hp.off; const int a = (16 * seg + r) * 136 + d;
        Qt[a] = (short)(cvt_pk_bf16(qv[r] * __expf(c - hp.cmid), 0.f) & 0xffffu);
        Kt[a] = (short)(cvt_pk_bf16(hp.kk[r] * __expf(hp.cmid - c), 0.f) & 0xffffu);
        Qc[a] = (short)(cvt_pk_bf16(qv[r] * __expf(c), 0.f) & 0xffffu);
    }
    __syncthreads();
    bf16x8 qf[4];
#pragma unroll
    for (int ks = 0; ks < 4; ++ks) qf[ks] = frag_nat(Qt, 136, t0, 32 * ks, fr, fq);
#pragma unroll
    for (int jt = 0; jt < 4; ++jt) {
        u32x2 sp = (u32x2){0u, 0u};
        if (jt <= rb) {
            f32x4 a = (f32x4){0.f, 0.f, 0.f, 0.f};
#pragma unroll
            for (int ks = 0; ks < 4; ++ks) a = MF(frag_nat(Kt, 136, 16 * jt, 32 * ks, fr, fq), qf[ks], a);
            float v[4];
#pragma unroll
            for (int r = 0; r < 4; ++r) { const int j = 16 * jt + 4 * fq + r; v[r] = (j <= trow) ? a[r] : 0.f; }
            sp.x = cvt_pk_bf16(v[0], v[1]); sp.y = cvt_pk_bf16(v[2], v[3]);
        }
        *(LAS u32x2*)(Sw + fr * 72 + 16 * jt + 4 * fq) = sp;
    }
    f32x4 o[4];
#pragma unroll
    for (int et = 0; et < 4; ++et) o[et] = (f32x4){0.f, 0.f, 0.f, 0.f};
#pragma unroll
    for (int ks = 0; ks < 4; ++ks) {
        const bf16x8 qcf = frag_nat(Qc, 136, t0, 32 * ks, fr, fq);
#pragma unroll
        for (int et = 0; et < 4; ++et) o[et] = MF(hsf[ks][et], qcf, o[et]);
    }
    __syncthreads();
#pragma unroll
    for (int ks = 0; ks < 2; ++ks) {
        const bf16x8 sf = frag_nat(Sw, 72, 0, 32 * ks, fr, fq);
#pragma unroll
        for (int et = 0; et < 4; ++et) o[et] = MF(frag_tr(Vi, 136, 32 * ks, 64 * eh + 16 * et, fr, fq), sf, o[et]);
    }
    float ss = 0.f;
#pragma unroll
    for (int et = 0; et < 4; ++et) ss += (o[et][0] * o[et][0] + o[et][1] * o[et][1]) + (o[et][2] * o[et][2] + o[et][3] * o[et][3]);
    ss += __shfl_xor(ss, 16); ss += __shfl_xor(ss, 32);
    if (fq == 0) ssx[eh * 64 + trow] = ss;
    __syncthreads();
    const float rstd = __builtin_amdgcn_rsqf((ssx[trow] + ssx[64 + trow]) * (1.f / 128.f) + EPS);
    const float* gn = C.in[9] + h * 128; bf16_t* prow = P + (size_t)(row0 + trow) * PP + h * 128;
#pragma unroll
    for (int et = 0; et < 4; ++et) {
        const int e = 64 * eh + 16 * et + 4 * fq; const f32x4 gg = *(const f32x4*)(gn + e); const u32x2 sg = sgv[et];
        const f32x4 y = o[et] * rstd * gg;
        u32x2 ov; ov.x = cvt_pk_bf16(y[0] * bflo(sg.x), y[1] * bfhi(sg.x)); ov.y = cvt_pk_bf16(y[2] * bflo(sg.y), y[3] * bfhi(sg.y));
        if (rowmask != 511 || ov.x == 0xDEADBEEFu) *(u32x2*)(Pdst + (size_t)((row0 + trow) & rowmask) * PP + h * 128 + COL_HQ + e) = ov;
    }
    __syncthreads();
}

struct Args { const float* in[16]; float* out; unsigned char* ws; int ph_lo, ph_hi; };
constexpr int N_PHASES = 11;

__global__ void __launch_bounds__(NTHR, 2) mega_fwd(Args args) {
    extern __shared__ __attribute__((aligned(16))) unsigned char lds_raw[];
    LAS unsigned char* lds = (LAS unsigned char*)lds_raw;
    Ctx C;
#pragma unroll
    for (int i = 0; i < 16; ++i) C.in[i] = args.in[i];
    C.out = args.out; C.ws = args.ws; C.tid = threadIdx.x; C.lane = C.tid & 63; C.wave = __builtin_amdgcn_readfirstlane(C.tid >> 6); C.G = gridDim.x; C.bx = blockIdx.x;
    const int lo = args.ph_lo, hi = args.ph_hi;
    unsigned char* ws = args.ws;
    bf16_t* WGU = (bf16_t*)(ws + WS_WGU); bf16_t* WDt = (bf16_t*)(ws + WS_WD); bf16_t* WIN = (bf16_t*)(ws + WS_WIN); bf16_t* WOUT = (bf16_t*)(ws + WS_WOUT);
    bf16_t* XN = (bf16_t*)(ws + WS_XN); bf16_t* HB = (bf16_t*)(ws + WS_H); bf16_t* PROJ = (bf16_t*)(ws + WS_PROJ);
    float* SS1 = (float*)(ws + WS_SS1); float* SS2 = (float*)(ws + WS_SS2); float* SS3 = (float*)(ws + WS_SS3);
#define IN(k) (lo <= (k) && (k) < hi)
    unsigned* barw = (unsigned*)(ws + WS_BAR);
    volatile LAS unsigned* misc = (volatile LAS unsigned*)(lds + LDS_MISC);
    if (C.tid < 2) misc[C.tid] = 0u;
    if (C.bx == 0 && hi - lo > 1) for (int i = C.tid; i < XCD_BAR_WORDS; i += NTHR) barw[i] = 0u;
    __syncthreads();
    XcdBarrier xbar; xbar.bar = barw; xbar.x = 0; xbar.st = misc;
#define SEAM(k) do { if (IN(k) && IN((k) + 1)) { if ((k) == 0) { cg::this_grid().sync(); xbar = xcd_barrier_post(barw, misc); } else xcd_barrier(xbar); } } while (0)

    if (IN(0)) { phase_prologue(C, lds);
#if MK_DUP == 0
        phase_prologue(C, lds);
#endif
    }
    SEAM(0);
#if MK_DUP == 20
    for (int r = 0; r < 10; ++r) cg::this_grid().sync();
#endif
    if (IN(1)) {
#if MK_DUP == 1
        { pg8::Gemm g{XN, WGU, M, 2 * FF, D, D}; pg8::StaticOrder S; S.init(M, 2 * FF, C.G, C.bx); pg8::EpiGateUp E{HB, nullptr, true}; pg8::gemm_phase(lds, g, S, E); }
#endif
        pg8::Gemm g{XN, WGU, M, 2 * FF, D, D}; pg8::StaticOrder S; S.init(M, 2 * FF, C.G, C.bx);
        pg8::EpiGateUp E{HB, nullptr, false}; pg8::gemm_phase(lds, g, S, E);
    }
    SEAM(1);
    if (IN(2)) {
        pg8::Gemm g{HB, WDt, M, D, FF, FF}; pg8::StaticOrder S; S.init(M, D, C.G, C.bx);
        pg8::EpiResid E{C.in[0], C.out, 0.5f, C.in[5], XN, SS1, nullptr}; pg8::gemm_phase(lds, g, S, E);
    }
    SEAM(2);
    if (IN(3)) {
        pg8::Gemm g{XN, WIN, M, NIN, D, D}; pg8::StaticOrder S; S.init(M, NIN, C.G, C.bx);
        pg8::EpiProj E{PROJ, SS1}; pg8::gemm_phase(lds, g, S, E);
    }
    SEAM(3);
    if (IN(4)) {
#if MK_DUP == 4
        for (int u = C.bx; u < 512 + 2048; u += C.G) { if (u < 512) ret_pass_a(C, lds, u); else hgrn_pass_a(C, lds, u - 512); }
#endif
        for (int u = C.bx; u < 512 + 1024; u += C.G) { if (u < 512) ret_pass_a(C, lds, u); else hgrn_pass_a2(C, lds, u - 512); }
    }
    SEAM(4);
    if (IN(5)) {
#if MK_DUP == 5
        for (int it = C.bx * NTHR + C.tid; it < 65536 + 32768; it += C.G * NTHR) scan_item<true>(C, it);
#endif
        for (int it = C.bx * NTHR + C.tid; it < 65536 + 32768; it += C.G * NTHR) scan_item<false>(C, it);
        LAS float* scr = (LAS float*)(lds + C.wave * 16384);
        for (int it = C.bx * NWAVES + C.wave; it < 3 * 5632; it += C.G * NWAVES) convert_ffn_item(it, C.in[12], C.in[13], C.in[14], WGU, WDt, scr, C.lane);
    }
    SEAM(5);
    if (IN(6)) {
#if MK_DUP == 6
        for (int u = C.bx; u < 512 + 2048; u += C.G) { if (u < 512) ret_pass_c<MK_SKIP>(C, lds, u, (bf16_t*)(ws + WS_END), 511); else hgrn_pass_c(C, lds, u - 512, (bf16_t*)(ws + WS_END), 511); }
#endif
#if MK_DUP == 61
        for (int u = C.bx; u < 512; u += C.G) ret_pass_c<MK_SKIP>(C, lds, u, (bf16_t*)(ws + WS_END), 511);
#endif
#if MK_DUP == 63
        for (int u = C.bx + 512; u < 512 + 1024; u += C.G) hgrn_pass_c2<8 | MK_SKIP>(C, lds, u - 512);
#endif
#if MK_DUP == 62
        for (int u = C.bx + 512; u < 512 + 2048; u += C.G) hgrn_pass_c(C, lds, u - 512, (bf16_t*)(ws + WS_END), 511);
#endif
#if MK_DUP == 41
        for (int u = C.bx; u < 512; u += C.G) ret_pass_a(C, lds, u);
#endif
        for (int u = C.bx; u < 512 + 1024; u += C.G) { if (u < 512) ret_pass_c<0>(C, lds, u, PROJ, 0x7fffffff); else hgrn_pass_c2<0>(C, lds, u - 512); }
    }
    SEAM(6);
    if (IN(7)) {
        pg8::Gemm g{PROJ, WOUT, M, D, D, PP}; pg8::StaticOrder S; S.init(M, D, C.G, C.bx);
        pg8::EpiResid E{C.out, C.out, 1.0f, C.in[11], XN, SS2, nullptr}; pg8::gemm_phase(lds, g, S, E);
    }
    SEAM(7);
    if (IN(8)) {
        pg8::Gemm g{XN, WGU, M, 2 * FF, D, D}; pg8::StaticOrder S; S.init(M, 2 * FF, C.G, C.bx);
        pg8::EpiGateUp E{HB, SS2, false}; pg8::gemm_phase(lds, g, S, E);
    }
    SEAM(8);
    if (IN(9)) {
        pg8::Gemm g{HB, WDt, M, D, FF, FF}; pg8::StaticOrder S; S.init(M, D, C.G, C.bx);
        pg8::EpiResid E{C.out, C.out, 0.5f, nullptr, nullptr, nullptr, XN}; pg8::gemm_phase(lds, g, S, E);
    }
    SEAM(9);
    if (IN(10)) {
        const float* gf = C.in[15];
        f32x4 gfv[4][2];
#pragma unroll
        for (int j = 0; j < 4; ++j) { gfv[j][0] = *((const f32x4*)gf + 2 * (64 * j + C.lane)); gfv[j][1] = *((const f32x4*)gf + 2 * (64 * j + C.lane) + 1); }
        {
            const int gw = C.bx * NWAVES + C.wave, NGW = C.G * NWAVES;
            u32x4 v[4], nv[4];
            if (gw < M) {
#pragma unroll
                for (int j = 0; j < 4; ++j) v[j] = *((const u32x4*)(XN + (size_t)gw * D) + C.lane + 64 * j);
            }
            for (int m = gw; m < M; m += NGW) {
                const int mn = (m + NGW < M) ? m + NGW : m;
#pragma unroll
                for (int j = 0; j < 4; ++j) nv[j] = *((const u32x4*)(XN + (size_t)mn * D) + C.lane + 64 * j);
                __builtin_amdgcn_sched_barrier(0);
                f32x4 x[4][2]; float ssum = 0.f;
#pragma unroll
                for (int j = 0; j < 4; ++j) {
                    x[j][0] = (f32x4){bflo(v[j].x), bfhi(v[j].x), bflo(v[j].y), bfhi(v[j].y)}; x[j][1] = (f32x4){bflo(v[j].z), bfhi(v[j].z), bflo(v[j].w), bfhi(v[j].w)};
#pragma unroll
                    for (int q = 0; q < 2; ++q) ssum += (x[j][q][0] * x[j][q][0] + x[j][q][1] * x[j][q][1]) + (x[j][q][2] * x[j][q][2] + x[j][q][3] * x[j][q][3]);
                }
                const float rs = 1.f / sqrtf(wave_sum(ssum) * (1.f / D) + EPS);
                f32x4* xr = (f32x4*)(C.out + (size_t)m * D);
#pragma unroll
                for (int j = 0; j < 4; ++j) { xr[2 * (64 * j + C.lane)] = x[j][0] * rs * gfv[j][0]; xr[2 * (64 * j + C.lane) + 1] = x[j][1] * rs * gfv[j][1]; }
                __builtin_amdgcn_sched_barrier(0);
#pragma unroll
                for (int j = 0; j < 4; ++j) v[j] = nv[j];
            }
        }
    }
#undef IN
#undef SEAM
}

extern "C" void kernel_launch(void* const* d_in, const int* in_sizes, int n_in, void* d_out, int out_size, void* d_ws, size_t ws_size, hipStream_t stream) {
    static int grid = 0;
    if (grid == 0) {
        if (n_in != 16 || out_size != M * D || ws_size < WS_END) { fprintf(stderr, "kernel_launch: unexpected shapes (n_in %d, out %d, ws %zu)\n", n_in, out_size, ws_size); grid = -1; return; }
        int dev = 0, cus = 0, per_cu = 0;
        hipGetDevice(&dev); hipDeviceGetAttribute(&cus, hipDeviceAttributeMultiprocessorCount, dev);
        if (hipFuncSetAttribute((const void*)mega_fwd, hipFuncAttributeMaxDynamicSharedMemorySize, LDS_BYTES) != hipSuccess) { fprintf(stderr, "kernel_launch: hipFuncSetAttribute failed\n"); grid = -1; return; }
        hipOccupancyMaxActiveBlocksPerMultiprocessor(&per_cu, (const void*)mega_fwd, NTHR, LDS_BYTES);
        if (per_cu < 1) { fprintf(stderr, "kernel_launch: occupancy query says %d blocks per CU\n", per_cu); per_cu = 1; }
        (void)hipGetLastError();
        grid = cus * 1;
        fprintf(stderr, "kernel_launch: grid %d (cus %d, per_cu %d)\n", grid, cus, per_cu);
    }
    if (grid < 0) return;
    Args a{};
    for (int i = 0; i < 16; ++i) a.in[i] = (const float*)d_in[i];
    a.out = (float*)d_out; a.ws = (unsigned char*)d_ws;
#if MK_PER_PHASE
#ifndef MK_LASTP
#define MK_LASTP 10
#endif
    for (int p = 0; p < N_PHASES; ++p) { if (p > MK_LASTP && p != 10) continue; a.ph_lo = p; a.ph_hi = p + 1; hipLaunchKernelGGL(mega_fwd, dim3(grid), dim3(NTHR), LDS_BYTES, stream, a); }
#else
    a.ph_lo = 0; a.ph_hi = N_PHASES;
    void* kargs[] = {&a};
    hipError_t e = hipLaunchCooperativeKernel((const void*)mega_fwd, dim3(grid), dim3(NTHR), kargs, LDS_BYTES, stream);
    if (e != hipSuccess) fprintf(stderr, "kernel_launch: cooperative launch failed: %s (grid %d)\n", hipGetErrorString(e), grid);
#endif
}
```
